# Optimizing an MI355X kernel written in HIP

```python
import math
import jax, jax.numpy as jnp
from jax import lax
import numpy as np


D_MODEL = 1024
BATCH = 8
SEQ = 2048
DEPTH = 4

D_FF = 2816
DEEPNORM_ALPHA = (2.0 * DEPTH) ** 0.25
DEEPNORM_BETA = (8.0 * DEPTH) ** -0.25
LN_EPS = 1e-5
RMS_EPS = 1e-6
CONV_K = 4

GDN_QK_HEADS = 4
GDN_V_HEADS = 8
GDN_DK = 128
GDN_DV = 128
GDN_CHUNK = 64
GDN_QK_W = GDN_QK_HEADS * GDN_DK
GDN_V_W = GDN_V_HEADS * GDN_DV
GDN_CONV_DIM = 2 * GDN_QK_W + GDN_V_W

SSD_D_INNER = D_MODEL
SSD_HEADDIM = 64
SSD_HEADS = SSD_D_INNER // SSD_HEADDIM
SSD_GROUPS = 2
SSD_STATE = 128
SSD_CHUNK = 128
SSD_CONV_DIM = SSD_D_INNER + 2 * SSD_GROUPS * SSD_STATE

HYB_IN = GDN_CONV_DIM + GDN_V_W + 2 * GDN_V_HEADS + SSD_D_INNER + SSD_CONV_DIM + SSD_HEADS
HYB_OUT = GDN_V_W + SSD_D_INNER

NSA_HEADS = 16
NSA_GROUPS = 2
NSA_DK = 64
NSA_DV = 64
ROPE_DIM = NSA_DK // 4
ROPE_THETA = 500000.0
CMP_LEN = 32
CMP_STRIDE = 16
CMP_HIDDEN = 256
SEL_LEN = 64
SEL_TOPK = 8
SEL_LOCAL = 2
FORCE_SCORE = 1e4
WINDOW = 512
Q_BLOCK = 128
NSA_IN = NSA_HEADS * NSA_DK + 3 * NSA_GROUPS * (NSA_DK + NSA_DV) + 3 * NSA_HEADS

kernel_name = 'hybrid_gdn_ssd_nsa_macaron_deepnorm'


def layer_norm(x, g, b):
    xf = x.astype(jnp.float32)
    mu = jnp.mean(xf, -1, keepdims=True)
    var = jnp.mean(jnp.square(xf - mu), -1, keepdims=True)
    return ((xf - mu) * lax.rsqrt(var + LN_EPS) * g + b).astype(x.dtype)


def rms_normalize(x):
    xf = x.astype(jnp.float32)
    return xf * lax.rsqrt(jnp.mean(jnp.square(xf), -1, keepdims=True) + RMS_EPS)


def l2_normalize(x):
    xf = x.astype(jnp.float32)
    return xf * lax.rsqrt(jnp.sum(jnp.square(xf), -1, keepdims=True) + 1e-6)


def swiglu(x, w_in, w_out):
    gate, up = jnp.split(x @ w_in, 2, axis=-1)
    return (jax.nn.silu(gate) * up) @ w_out


def causal_conv(x, w):
    k, c = w.shape
    return lax.conv_general_dilated(x, w[:, None, :].astype(x.dtype), window_strides=(1,),
                                    padding=[(k - 1, 0)], dimension_numbers=('NWC', 'WIO', 'NWC'),
                                    feature_group_count=c)


def decay_matrix(cs):
    n = cs.shape[-1]
    mask = np.tril(np.ones((n, n), dtype=bool))
    return jnp.exp(jnp.where(mask, cs[..., :, None] - cs[..., None, :], -jnp.inf))


def masked_softmax(s, mask):
    s = jnp.where(mask, s.astype(jnp.float32), -jnp.inf)
    m = jnp.max(s, -1, keepdims=True)
    m = jnp.where(jnp.isfinite(m), m, 0.0)
    e = jnp.exp(s - m)
    return e / jnp.maximum(jnp.sum(e, -1, keepdims=True), 1e-30)


def partial_rope(x, positions):
    half = ROPE_DIM // 2
    inv_freq = jnp.asarray(ROPE_THETA ** (-np.arange(half) / half), jnp.float32)
    ang = positions.astype(jnp.float32)[..., None] * inv_freq
    cos = jnp.cos(ang)[:, :, None, :]
    sin = jnp.sin(ang)[:, :, None, :]
    xf = x.astype(jnp.float32)
    x1, x2, rest = xf[..., :half], xf[..., half:ROPE_DIM], xf[..., ROPE_DIM:]
    out = jnp.concatenate([x1 * cos - x2 * sin, x2 * cos + x1 * sin, rest], axis=-1)
    return out.astype(x.dtype)


def gated_delta_rule(q, k, v, g, beta):
    bsz, t_len, h, dk = q.shape
    dv = v.shape[-1]
    c = GDN_CHUNK
    n = t_len // c

    def to_chunks(a):
        return a.astype(jnp.float32).reshape(bsz, n, c, h, -1).transpose(0, 3, 1, 2, 4)

    q, k, v = to_chunks(q), to_chunks(k), to_chunks(v)
    g = g.astype(jnp.float32).reshape(bsz, n, c, h).transpose(0, 3, 1, 2)
    beta = beta.astype(jnp.float32).reshape(bsz, n, c, h).transpose(0, 3, 1, 2)
    g_cum = jnp.cumsum(g, axis=-1)
    decay = decay_matrix(g_cum)
    strict = np.tril(np.ones((c, c), dtype=bool), -1)
    k_beta = k * beta[..., None]
    a_low = jnp.where(strict, jnp.einsum('bhncd,bhnsd->bhncs', k_beta, k) * decay, 0.0)
    rhs = jnp.concatenate([v * beta[..., None], k_beta * jnp.exp(g_cum)[..., None]], axis=-1)
    sol = lax.linalg.triangular_solve(a_low, rhs, left_side=True, lower=True, unit_diagonal=True)
    u, w = sol[..., :dv], sol[..., dv:]
    attn = jnp.einsum('bhncd,bhnsd->bhncs', q, k) * decay
    q_dec = q * jnp.exp(g_cum)[..., None]
    k_dec = k * jnp.exp(g_cum[..., -1:] - g_cum)[..., None]
    chunk_dec = jnp.exp(g_cum[..., -1])

    def step(state, inp):
        u_c, w_c, q_c, k_c, a_c, d_c = inp
        v_new = u_c - jnp.einsum('bhck,bhkv->bhcv', w_c, state)
        o_c = jnp.einsum('bhck,bhkv->bhcv', q_c, state) + jnp.einsum('bhcs,bhsv->bhcv', a_c, v_new)
        state = state * d_c[..., None, None] + jnp.einsum('bhck,bhcv->bhkv', k_c, v_new)
        return state, o_c

    xs = tuple(jnp.moveaxis(a, 2, 0) for a in (u, w, q_dec, k_dec, attn, chunk_dec))
    s0 = jnp.zeros((bsz, h, dk, dv), jnp.float32)
    _, o = lax.scan(step, s0, xs)
    return o.transpose(1, 0, 3, 2, 4).reshape(bsz, t_len, h, dv)


def gdn_branch(qkv, z, b_logit, a_logit, conv_w, a_log, dt_bias, norm_w):
    bsz, t_len, _ = qkv.shape
    qkv = jax.nn.silu(causal_conv(qkv, conv_w))
    q, k, v = jnp.split(qkv, [GDN_QK_W, 2 * GDN_QK_W], axis=-1)
    rep = GDN_V_HEADS // GDN_QK_HEADS
    q = jnp.repeat(l2_normalize(q.reshape(bsz, t_len, GDN_QK_HEADS, GDN_DK)) * (GDN_DK ** -0.5), rep, axis=2)
    k = jnp.repeat(l2_normalize(k.reshape(bsz, t_len, GDN_QK_HEADS, GDN_DK)), rep, axis=2)
    v = v.reshape(bsz, t_len, GDN_V_HEADS, GDN_DV)
    beta = jax.nn.sigmoid(b_logit.astype(jnp.float32))
    g = -jnp.exp(a_log.astype(jnp.float32)) * jax.nn.softplus(a_logit.astype(jnp.float32) + dt_bias)
    o = gated_delta_rule(q, k, v, g, beta)
    zf = z.reshape(bsz, t_len, GDN_V_HEADS, GDN_DV).astype(jnp.float32)
    o = rms_normalize(o) * norm_w * jax.nn.silu(zf)
    return o.reshape(bsz, t_len, GDN_V_W).astype(qkv.dtype)


def ssd_scan(x, dt, a, bm, cm):
    bsz, t_len, h, p = x.shape
    g, n = bm.shape[2], bm.shape[3]
    e = h // g
    l = SSD_CHUNK
    nc = t_len // l
    x = x.astype(jnp.float32)
    dt = dt.astype(jnp.float32)
    xdt = (x * dt[..., None]).reshape(bsz, nc, l, g, e, p)
    adt = (dt * a).reshape(bsz, nc, l, g, e).transpose(0, 3, 4, 1, 2)
    bm = bm.astype(jnp.float32).reshape(bsz, nc, l, g, n)
    cm = cm.astype(jnp.float32).reshape(bsz, nc, l, g, n)
    a_cs = jnp.cumsum(adt, axis=-1)
    seg = decay_matrix(a_cs)
    cb = jnp.einsum('bclgn,bcsgn->bgcls', cm, bm)
    y_diag = jnp.einsum('bgcls,bgecls,bcsgep->bclgep', cb, seg, xdt)
    decay_states = jnp.exp(a_cs[..., -1:] - a_cs)
    states = jnp.einsum('bclgn,bgecl,bclgep->bcgepn', bm, decay_states, xdt)
    chunk_cs = jnp.cumsum(jnp.pad(a_cs[..., -1], ((0, 0), (0, 0), (0, 0), (1, 0))), axis=-1)
    decay_chunk = decay_matrix(chunk_cs)
    states = jnp.concatenate([jnp.zeros_like(states[:, :1]), states], axis=1)
    prev = jnp.einsum('bgezc,bcgepn->bzgepn', decay_chunk, states)[:, :-1]
    y_off = jnp.einsum('bclgn,bcgepn,bgecl->bclgep', cm, prev, jnp.exp(a_cs))
    return (y_diag + y_off).reshape(bsz, t_len, h, p)


def ssd_branch(z, xbc, dt_logit, conv_w, conv_b, a_log, dt_bias, d_skip, norm_w):
    bsz, t_len, _ = xbc.shape
    xbc = jax.nn.silu(causal_conv(xbc, conv_w) + conv_b)
    xs, bm, cm = jnp.split(xbc, [SSD_D_INNER, SSD_D_INNER + SSD_GROUPS * SSD_STATE], axis=-1)
    x = xs.reshape(bsz, t_len, SSD_HEADS, SSD_HEADDIM)
    bm = bm.reshape(bsz, t_len, SSD_GROUPS, SSD_STATE)
    cm = cm.reshape(bsz, t_len, SSD_GROUPS, SSD_STATE)
    dt = jax.nn.softplus(dt_logit.astype(jnp.float32) + dt_bias)
    a = -jnp.exp(a_log.astype(jnp.float32))
    y = ssd_scan(x, dt, a, bm, cm) + x.astype(jnp.float32) * d_skip[:, None]
    y = y.reshape(bsz, t_len, SSD_D_INNER) * jax.nn.silu(z.astype(jnp.float32))
    y = rms_normalize(y.reshape(bsz, t_len, SSD_GROUPS, -1)) * norm_w.reshape(SSD_GROUPS, -1)
    return y.reshape(bsz, t_len, SSD_D_INNER).astype(xbc.dtype)


def hybrid_mixer(x, w_in, gdn_conv_w, gdn_a_log, gdn_dt_bias, gdn_norm_w,
                 ssd_conv_w, ssd_conv_b, ssd_a_log, ssd_dt_bias, ssd_d, ssd_norm_w, w_out):
    proj = x @ w_in
    sizes = [GDN_CONV_DIM, GDN_V_W, GDN_V_HEADS, GDN_V_HEADS, SSD_D_INNER, SSD_CONV_DIM]
    gdn_qkv, gdn_z, gdn_b, gdn_a, ssd_z, ssd_xbc, ssd_dt = jnp.split(
        proj, [int(s) for s in np.cumsum(sizes)], axis=-1)
    o_a = gdn_branch(gdn_qkv, gdn_z, gdn_b, gdn_a, gdn_conv_w, gdn_a_log, gdn_dt_bias, gdn_norm_w)
    o_b = ssd_branch(ssd_z, ssd_xbc, ssd_dt, ssd_conv_w, ssd_conv_b, ssd_a_log, ssd_dt_bias, ssd_d, ssd_norm_w)
    return jnp.concatenate([o_a, o_b], axis=-1) @ w_out


def compress_blocks(kv, idx, pos, w1, w2):
    bsz, _, g, d = kv.shape
    blocks = kv[:, idx] + pos[:, None, :]
    flat = blocks.transpose(0, 1, 3, 2, 4).reshape(bsz, idx.shape[0], g, CMP_LEN * d)
    return jax.nn.silu(flat @ w1) @ w2


def nsa_mixer(x, positions, w_in, cmp_pos, cmp_w1, cmp_w2, w_out):
    bsz, t_len, _ = x.shape
    h, g, dk, dv = NSA_HEADS, NSA_GROUPS, NSA_DK, NSA_DV
    e = h // g
    proj = x @ w_in
    sizes = [h * dk, g * dk, g * dv, g * dk, g * dv, g * dk, g * dv]
    q, k_c, v_c, k_s, v_s, k_w, v_w, gates = jnp.split(proj, [int(s) for s in np.cumsum(sizes)], axis=-1)
    q = q.reshape(bsz, t_len, h, dk)
    k_c, k_s, k_w = (a.reshape(bsz, t_len, g, dk) for a in (k_c, k_s, k_w))
    v_c, v_s, v_w = (a.reshape(bsz, t_len, g, dv) for a in (v_c, v_s, v_w))
    q_rot = partial_rope(q, positions)
    k_s = partial_rope(k_s, positions)
    k_w = partial_rope(k_w, positions)
    gates = jax.nn.sigmoid(gates.astype(jnp.float32)).reshape(bsz, t_len, h, 3)

    n_cmp = (t_len - CMP_LEN) // CMP_STRIDE + 1
    cmp_idx = np.arange(n_cmp)[:, None] * CMP_STRIDE + np.arange(CMP_LEN)[None, :]
    k_cmp = compress_blocks(k_c, cmp_idx, cmp_pos[0], cmp_w1[0], cmp_w2[0])
    v_cmp = compress_blocks(v_c, cmp_idx, cmp_pos[1], cmp_w1[1], cmp_w2[1])
    cmp_end = jnp.asarray(cmp_idx[:, -1], jnp.int32)

    n_sel = t_len // SEL_LEN
    n_top = min(SEL_TOPK, n_sel)
    c0 = np.arange(n_cmp)[:, None] * CMP_STRIDE
    s0 = np.arange(n_sel)[None, :] * SEL_LEN
    agg = np.clip(np.minimum(c0 + CMP_LEN, s0 + SEL_LEN) - np.maximum(c0, s0), 0, None) / CMP_LEN
    agg = jnp.asarray(agg, jnp.float32)
    k_blocks = k_s.reshape(bsz, n_sel, SEL_LEN, g, dk).transpose(0, 3, 1, 2, 4)
    v_blocks = v_s.reshape(bsz, n_sel, SEL_LEN, g, dv).transpose(0, 3, 1, 2, 4)
    k_win = jnp.pad(k_w, ((0, 0), (WINDOW, 0), (0, 0), (0, 0)))
    v_win = jnp.pad(v_w, ((0, 0), (WINDOW, 0), (0, 0), (0, 0)))

    n_q = t_len // Q_BLOCK

    def to_blocks(a):
        return a.reshape(bsz, n_q, Q_BLOCK, *a.shape[2:]).swapaxes(0, 1)

    xs = (to_blocks(q), to_blocks(q_rot), to_blocks(gates), jnp.arange(n_q, dtype=jnp.int32) * Q_BLOCK)
    scale = dk ** -0.5
    b_ix = jnp.arange(bsz)[:, None, None]
    g_ix = jnp.arange(g)[None, :, None]
    sel_ids = jnp.arange(n_sel)

    def query_block(inp):
        qb, qrb, gb, q0 = inp
        t = q0 + jnp.arange(Q_BLOCK)
        qg = qb.reshape(bsz, Q_BLOCK, g, e, dk)
        qrg = qrb.reshape(bsz, Q_BLOCK, g, e, dk)
        s_cmp = jnp.einsum('bqged,bcgd->bgeqc', qg, k_cmp) * scale
        p_cmp = masked_softmax(s_cmp, cmp_end[None, :] <= t[:, None])
        o_cmp = jnp.einsum('bgeqc,bcgd->bqged', p_cmp, v_cmp)
        importance = jnp.einsum('bgeqc,cj->bgqj', p_cmp, agg)
        cur = t // SEL_LEN
        causal_blk = sel_ids[None, :] <= cur[:, None]
        forced = (sel_ids[None, :] == 0) | (causal_blk & (sel_ids[None, :] > cur[:, None] - SEL_LOCAL))
        score = jnp.where(forced, FORCE_SCORE, jnp.where(causal_blk, importance, -1.0))
        _, top = lax.top_k(score, n_top)
        flat = top.reshape(bsz, g, Q_BLOCK * n_top)
        k_sel = k_blocks[b_ix, g_ix, flat].reshape(bsz, g, Q_BLOCK, n_top * SEL_LEN, dk)
        v_sel = v_blocks[b_ix, g_ix, flat].reshape(bsz, g, Q_BLOCK, n_top * SEL_LEN, dv)
        key_pos = (top[..., None] * SEL_LEN + jnp.arange(SEL_LEN)).reshape(bsz, g, Q_BLOCK, n_top * SEL_LEN)
        s_sel = jnp.einsum('bqged,bgqmd->bgeqm', qrg, k_sel) * scale
        p_sel = masked_softmax(s_sel, (key_pos <= t[:, None])[:, :, None])
        o_sel = jnp.einsum('bgeqm,bgqmd->bqged', p_sel, v_sel)
        kw = lax.dynamic_slice_in_dim(k_win, q0, WINDOW + Q_BLOCK, axis=1)
        vw = lax.dynamic_slice_in_dim(v_win, q0, WINDOW + Q_BLOCK, axis=1)
        win_pos = q0 - WINDOW + jnp.arange(WINDOW + Q_BLOCK)
        win_mask = ((win_pos[None, :] <= t[:, None]) & (win_pos[None, :] > t[:, None] - WINDOW)
                    & (win_pos[None, :] >= 0))
        s_win = jnp.einsum('bqged,bkgd->bgeqk', qrg, kw) * scale
        p_win = masked_softmax(s_win, win_mask)
        o_win = jnp.einsum('bgeqk,bkgd->bqged', p_win, vw)
        gb = gb.reshape(bsz, Q_BLOCK, g, e, 3)
        o = gb[..., 0:1] * o_cmp + gb[..., 1:2] * o_sel + gb[..., 2:3] * o_win
        return o.reshape(bsz, Q_BLOCK, h * dv)

    o = lax.map(query_block, xs)
    o = o.swapaxes(0, 1).reshape(bsz, t_len, h * dv).astype(x.dtype)
    return o @ w_out


def setup_inputs(seed: int = 0) -> dict:
    key = jax.random.key(seed)
    keys = list(jax.random.split(key, 32))
    n_hyb = (DEPTH + 1) // 2
    n_nsa = DEPTH // 2

    def normal(i, shape, s):
        return jax.random.normal(keys[i], shape, jnp.float32) * s

    def dt_bias(i, shape):
        dt = jnp.exp(jax.random.uniform(keys[i], shape, jnp.float32, math.log(1e-3), math.log(1e-1)))
        return dt + jnp.log(-jnp.expm1(-dt))

    def log_rate(i, shape):
        return jnp.log(jax.random.uniform(keys[i], shape, jnp.float32, 1.0, 16.0))

    x = normal(0, (BATCH, SEQ, D_MODEL), 1.0)
    positions = (jnp.arange(SEQ, dtype=jnp.int32)[None, :]
                 + jax.random.randint(keys[1], (BATCH, 1), 0, 4096, dtype=jnp.int32))
    return {
        'x': x,
        'positions': positions,
        'ln_g': 1.0 + normal(2, (DEPTH, 3, D_MODEL), 0.05),
        'ln_b': normal(3, (DEPTH, 3, D_MODEL), 0.02),
        'ffn_w_in': normal(4, (DEPTH, 2, D_MODEL, 2 * D_FF), D_MODEL ** -0.5),
        'ffn_w_out': normal(5, (DEPTH, 2, D_FF, D_MODEL), DEEPNORM_BETA * D_FF ** -0.5),
        'hyb_w_in': normal(6, (n_hyb, D_MODEL, HYB_IN), D_MODEL ** -0.5),
        'gdn_conv_w': normal(7, (n_hyb, CONV_K, GDN_CONV_DIM), CONV_K ** -0.5),
        'gdn_a_log': log_rate(8, (n_hyb, GDN_V_HEADS)),
        'gdn_dt_bias': dt_bias(9, (n_hyb, GDN_V_HEADS)),
        'gdn_norm_w': 1.0 + normal(10, (n_hyb, GDN_DV), 0.05),
        'ssd_conv_w': normal(11, (n_hyb, CONV_K, SSD_CONV_DIM), CONV_K ** -0.5),
        'ssd_conv_b': normal(12, (n_hyb, SSD_CONV_DIM), 0.02),
        'ssd_a_log': log_rate(13, (n_hyb, SSD_HEADS)),
        'ssd_dt_bias': dt_bias(14, (n_hyb, SSD_HEADS)),
        'ssd_d': 1.0 + normal(15, (n_hyb, SSD_HEADS), 0.05),
        'ssd_norm_w': 1.0 + normal(16, (n_hyb, SSD_D_INNER), 0.05),
        'hyb_w_out': normal(17, (n_hyb, HYB_OUT, D_MODEL), DEEPNORM_BETA * HYB_OUT ** -0.5),
        'nsa_w_in': normal(18, (n_nsa, D_MODEL, NSA_IN), D_MODEL ** -0.5),
        'nsa_cmp_pos': normal(19, (n_nsa, 2, CMP_LEN, NSA_DK), 0.1),
        'nsa_cmp_w1': normal(20, (n_nsa, 2, CMP_LEN * NSA_DK, CMP_HIDDEN), (CMP_LEN * NSA_DK) ** -0.5),
        'nsa_cmp_w2': normal(21, (n_nsa, 2, CMP_HIDDEN, NSA_DK), CMP_HIDDEN ** -0.5),
        'nsa_w_out': normal(22, (n_nsa, NSA_HEADS * NSA_DV, D_MODEL), DEEPNORM_BETA * (NSA_HEADS * NSA_DV) ** -0.5),
    }


def reference(x, positions, ln_g, ln_b, ffn_w_in, ffn_w_out, hyb_w_in, gdn_conv_w, gdn_a_log,
              gdn_dt_bias, gdn_norm_w, ssd_conv_w, ssd_conv_b, ssd_a_log, ssd_dt_bias, ssd_d,
              ssd_norm_w, hyb_w_out, nsa_w_in, nsa_cmp_pos, nsa_cmp_w1, nsa_cmp_w2, nsa_w_out):
    h = x
    for layer in range(DEPTH):
        i = layer // 2
        h = layer_norm(DEEPNORM_ALPHA * h + 0.5 * swiglu(h, ffn_w_in[layer, 0], ffn_w_out[layer, 0]),
                       ln_g[layer, 0], ln_b[layer, 0])
        if layer % 2 == 0:
            mix = hybrid_mixer(h, hyb_w_in[i], gdn_conv_w[i], gdn_a_log[i], gdn_dt_bias[i], gdn_norm_w[i],
                               ssd_conv_w[i], ssd_conv_b[i], ssd_a_log[i], ssd_dt_bias[i], ssd_d[i],
                               ssd_norm_w[i], hyb_w_out[i])
        else:
            mix = nsa_mixer(h, positions, nsa_w_in[i], nsa_cmp_pos[i], nsa_cmp_w1[i], nsa_cmp_w2[i], nsa_w_out[i])
        h = layer_norm(DEEPNORM_ALPHA * h + mix, ln_g[layer, 1], ln_b[layer, 1])
        h = layer_norm(DEEPNORM_ALPHA * h + 0.5 * swiglu(h, ffn_w_in[layer, 1], ffn_w_out[layer, 1]),
                       ln_g[layer, 2], ln_b[layer, 2])
    return h
```

```cpp
#include <hip/hip_runtime.h>
#include <hip/hip_bf16.h>
#include <hip/hip_cooperative_groups.h>
#include <cstdio>
#include <cstdint>
namespace cg = cooperative_groups;

typedef unsigned short u16;
using bf16x8 = __attribute__((ext_vector_type(8))) short;
using s16x4  = __attribute__((ext_vector_type(4))) short;
using f32x16 = __attribute__((ext_vector_type(16))) float;
using v2f = __attribute__((ext_vector_type(2))) float;

#ifndef USE_COOP
#define USE_COOP 1
#endif
#ifndef SKIP_MIX
#define SKIP_MIX 0
#endif

#define DI __device__ __forceinline__

constexpr int M_TOK = 16384;
constexpr int T_SEQ = 2048;
constexpr int DM = 1024;
constexpr int DFF = 2816;
constexpr int HYB_IN_N = 5664, HYB_IN_NP = 5888;
constexpr int NSA_IN_N = 1840, NSA_IN_NP = 2048;
constexpr float ALPHA = 1.681792830507429f;
constexpr int NTHREADS = 512;

constexpr size_t al(size_t x) { return (x + 255) & ~size_t(255); }
constexpr size_t OFF_W_FIN0 = 0;
constexpr size_t SZ_W_FIN = (size_t)5632 * 1024 * 2;
constexpr size_t OFF_W_FIN1 = OFF_W_FIN0 + SZ_W_FIN;
constexpr size_t OFF_W_FOUT0 = OFF_W_FIN1 + SZ_W_FIN;
constexpr size_t SZ_W_FOUT = (size_t)1024 * 2816 * 2;
constexpr size_t OFF_W_FOUT1 = OFF_W_FOUT0 + SZ_W_FOUT;
constexpr size_t OFF_W_MIN = OFF_W_FOUT1 + SZ_W_FOUT;
constexpr size_t SZ_W_MIN = (size_t)HYB_IN_NP * 1024 * 2;
constexpr size_t OFF_W_MOUT = OFF_W_MIN + SZ_W_MIN;
constexpr size_t SZ_W_MOUT = (size_t)1024 * 2048 * 2;
constexpr size_t OFF_W_C1 = OFF_W_MOUT + SZ_W_MOUT;
constexpr size_t SZ_W_C1 = (size_t)256 * 2048 * 2;
constexpr size_t OFF_W_C2 = OFF_W_C1 + 2 * SZ_W_C1;
constexpr size_t SZ_W_C2 = (size_t)256 * 256 * 2;
constexpr size_t OFF_STATS = al(OFF_W_C2 + 2 * SZ_W_C2);
constexpr size_t OFF_BAR = al(OFF_STATS + (size_t)M_TOK * 8);
constexpr size_t OFF_H = al(OFF_BAR + 5632 * 4);
constexpr size_t OFF_HB = OFF_H + (size_t)M_TOK * DM * 4;
constexpr size_t OFF_R = OFF_HB + (size_t)M_TOK * DM * 2;
constexpr size_t OFF_ACT = OFF_R;
constexpr size_t OFF_PROJ = OFF_R;
constexpr size_t OFF_GLOG = OFF_PROJ + (size_t)M_TOK * HYB_IN_N * 2;
constexpr size_t OFF_SDTL = OFF_GLOG + (size_t)M_TOK * 16 * 4;
constexpr size_t OFF_GQ = OFF_SDTL + (size_t)M_TOK * 16 * 4;
constexpr size_t OFF_GK = OFF_GQ + (size_t)M_TOK * 512 * 4;
constexpr size_t OFF_GV = OFF_GK + (size_t)M_TOK * 512 * 4;
constexpr size_t OFF_GA = OFF_GV + (size_t)M_TOK * 1024 * 4;
constexpr size_t OFF_GB = OFF_GA + (size_t)M_TOK * 8 * 4;
constexpr size_t OFF_SX = OFF_GB + (size_t)M_TOK * 8 * 4;
constexpr size_t OFF_SB = OFF_SX + (size_t)M_TOK * 1024 * 4;
constexpr size_t OFF_SC = OFF_SB + (size_t)M_TOK * 256 * 4;
constexpr size_t OFF_SDT = OFF_SC + (size_t)M_TOK * 256 * 4;
constexpr size_t OFF_SDA = OFF_SDT + (size_t)M_TOK * 16 * 4;
constexpr size_t OFF_O = OFF_SDA + (size_t)M_TOK * 16 * 4;
constexpr size_t OFF_END_HYB = OFF_O + (size_t)M_TOK * 2048 * 2;
constexpr size_t OFF_NGATE = OFF_PROJ + (size_t)M_TOK * HYB_IN_N * 2;
constexpr size_t OFF_QROT = OFF_NGATE + (size_t)M_TOK * 48 * 4;
constexpr size_t OFF_KSR = OFF_QROT + (size_t)M_TOK * 256 * 2;
constexpr size_t OFF_KWR = OFF_KSR + (size_t)M_TOK * 128 * 2;
constexpr size_t OFF_FLATK = OFF_KWR + (size_t)M_TOK * 128 * 2;
constexpr size_t OFF_FLATV = OFF_FLATK + (size_t)2048 * 2048 * 2;
constexpr size_t OFF_HIDK = OFF_FLATV + (size_t)2048 * 2048 * 2;
constexpr size_t OFF_HIDV = OFF_HIDK + (size_t)2048 * 256 * 2;
constexpr size_t OFF_KCMP = OFF_HIDV + (size_t)2048 * 256 * 2;
constexpr size_t OFF_VCMP = OFF_KCMP + (size_t)2048 * 64 * 2;
constexpr size_t OFF_NO = OFF_VCMP + (size_t)2048 * 64 * 2;

struct Params {
  const float* x; const int* pos;
  const float *ln_g, *ln_b, *ffn_w_in, *ffn_w_out, *hyb_w_in, *gdn_conv_w, *gdn_a_log, *gdn_dt_bias, *gdn_norm_w;
  const float *ssd_conv_w, *ssd_conv_b, *ssd_a_log, *ssd_dt_bias, *ssd_d, *ssd_norm_w, *hyb_w_out;
  const float *nsa_w_in, *nsa_cmp_pos, *nsa_cmp_w1, *nsa_cmp_w2, *nsa_w_out;
  float* out;
  char* ws;
  int wave; int pad_;
};

DI int ltid_(int wv) { int t = (wv << 6) | (int)__builtin_amdgcn_mbcnt_hi(~0u, __builtin_amdgcn_mbcnt_lo(~0u, 0u)); asm volatile("" : "+v"(t)); return t; }
#define ltid() ltid_(wv_)
DI int lbid() { int t = blockIdx.x; asm volatile("" : "+s"(t)); return t; }
typedef __bf16 bf16v2 __attribute__((ext_vector_type(2)));
DI u16 f2bf(float x) { return __builtin_bit_cast(u16, (__bf16)x); }
DI float bf2f(u16 v) { return __uint_as_float(((unsigned)v) << 16); }
DI unsigned pack2(float a, float b) { v2f v = {a, b}; return __builtin_bit_cast(unsigned, __builtin_convertvector(v, bf16v2)); }
DI float4 ld4bf(const u16* p) { const uint2 u = *(const uint2*)p; return make_float4(__uint_as_float(u.x << 16), __uint_as_float(u.x & 0xffff0000u), __uint_as_float(u.y << 16), __uint_as_float(u.y & 0xffff0000u)); }
DI void st4bf(u16* p, float4 v) { uint2 u; u.x = pack2(v.x, v.y); u.y = pack2(v.z, v.w); *(uint2*)p = u; }
DI float silu_f(float x) { return x * __builtin_amdgcn_rcpf(1.f + __expf(-x)); }
DI float sigmoid_acc(float x) { return 1.f / (1.f + expf(-x)); }
DI float softplus_acc(float x) { return fmaxf(x, 0.f) + log1pf(expf(-fabsf(x))); }
#define DPP_ADD(v, ctrl) (v) += __int_as_float(__builtin_amdgcn_update_dpp(0, __float_as_int(v), (ctrl), 0xF, 0xF, false))
DI float red16(float v) {
  DPP_ADD(v, 0xB1); DPP_ADD(v, 0x4E); DPP_ADD(v, 0x141); DPP_ADD(v, 0x140);
  return v;
}
DI float wave_sum(float v) {
  v = red16(v);
  const int iv = __float_as_int(v);
  return __int_as_float(__builtin_amdgcn_readlane(iv, 0)) + __int_as_float(__builtin_amdgcn_readlane(iv, 16)) +
         __int_as_float(__builtin_amdgcn_readlane(iv, 32)) + __int_as_float(__builtin_amdgcn_readlane(iv, 48));
}
DI float swap32(float v, int lane) {
  return __int_as_float(__builtin_amdgcn_ds_bpermute((lane ^ 32) << 2, __float_as_int(v)));
}
DI int crow(int i, int h) { return (i & 3) + 8 * (i >> 2) + 4 * h; }
#define MFMA32(a, b, c) __builtin_amdgcn_mfma_f32_32x32x16_bf16((a), (b), (c), 0, 0, 0)

DI void convT(const float* __restrict__ src, u16* __restrict__ dst, int K, int N, int Npad, int mode, char* smem, int wv_) {
  float* tl = (float*)smem;
  const int tid = ltid();
  const int tk = K / 64, tn = Npad / 128;
  const int ntile = tk * tn;
  const int lk = tid >> 7, ln = tid & 127;
  float rv[16];
  int tile = lbid();
  if (tile < ntile) {
    const int k0 = (tile % tk) * 64, n0 = (tile / tk) * 128;
#pragma unroll
    for (int r = 0; r < 16; ++r) rv[r] = (n0 + ln < N) ? src[(size_t)(k0 + r * 4 + lk) * N + n0 + ln] : 0.f;
  }
  for (; tile < ntile; tile += gridDim.x) {
    const int k0 = (tile % tk) * 64, n0 = (tile / tk) * 128;
    __syncthreads();
#pragma unroll
    for (int r = 0; r < 16; ++r) tl[(r * 4 + lk) * 129 + ln] = rv[r];
    __syncthreads();
    const int nxt = tile + gridDim.x;
    if (nxt < ntile) {
      const int k1 = (nxt % tk) * 64, n1 = (nxt / tk) * 128;
#pragma unroll
      for (int r = 0; r < 16; ++r) rv[r] = (n1 + ln < N) ? src[(size_t)(k1 + r * 4 + lk) * N + n1 + ln] : 0.f;
    }
#pragma unroll
    for (int r = 0; r < 8; ++r) {
      const int n = r * 16 + (tid >> 5), kk = (tid & 31) * 2;
      const int ng = n0 + n;
      int row = ng;
      if (mode == 1) { int up = ng >= DFF; int j = ng - up * DFF; row = (j >> 4) * 32 + up * 16 + (j & 15); }
      *(unsigned*)(dst + (size_t)row * K + k0 + kk) = pack2(tl[kk * 129 + n], tl[(kk + 1) * 129 + n]);
    }
  }
}

#define XCD_AFF_DECL const int xa_x = lbid() & 7, xa_slot = (lbid() >> 3) * (NTHREADS / 64) + (ltid() >> 6), xa_wpx = (int)(gridDim.x >> 3) * (NTHREADS / 64); \
  const bool xa_on = ((int)(gridDim.x >> 3) << 3) == (int)gridDim.x
DI void ln_phase(float* __restrict__ h, u16* __restrict__ hb, const float* __restrict__ g, const float* __restrict__ b, float* __restrict__ outp, float* __restrict__ stats, int wv_) {
  const int lane = ltid() & 63;
  XCD_AFF_DECL;
  const int wave = xa_on ? xa_slot : ((lbid() * NTHREADS + ltid()) >> 6), nw = xa_on ? xa_wpx : (int)gridDim.x * (NTHREADS / 64);
  const int rbase = xa_on ? xa_x * (M_TOK / 8) : 0, rcnt = xa_on ? M_TOK / 8 : M_TOK;
  for (int rr = wave; rr < rcnt; rr += nw) {
    const int row = rbase + rr;
    float4 v[4];
    float s = 0.f;
#pragma unroll
    for (int i = 0; i < 4; ++i) { v[i] = *(const float4*)(h + (size_t)row * DM + i * 256 + lane * 4); s += v[i].x + v[i].y + v[i].z + v[i].w; }
    s = wave_sum(s);
    const float mu = s * (1.f / DM);
    float q = 0.f;
#pragma unroll
    for (int i = 0; i < 4; ++i) { float a = v[i].x - mu, bb = v[i].y - mu, c = v[i].z - mu, d = v[i].w - mu; q += a * a + bb * bb + c * c + d * d; }
    q = wave_sum(q);
    const float rstd = rsqrtf(q * (1.f / DM) + 1e-5f);
    if (lane == 0) *(float2*)(stats + (size_t)row * 2) = make_float2(mu, rstd);
#pragma unroll
    for (int i = 0; i < 4; ++i) {
      const int col = i * 256 + lane * 4;
      float4 gg = *(const float4*)(g + col), bb = *(const float4*)(b + col);
      float4 y;
      y.x = (v[i].x - mu) * rstd * gg.x + bb.x; y.y = (v[i].y - mu) * rstd * gg.y + bb.y;
      y.z = (v[i].z - mu) * rstd * gg.z + bb.z; y.w = (v[i].w - mu) * rstd * gg.w + bb.w;
      if (outp) { *(float4*)(outp + (size_t)row * DM + col) = y; }
      else {
        uint2 pk; pk.x = pack2(y.x, y.y); pk.y = pack2(y.z, y.w);
        *(uint2*)(hb + (size_t)row * DM + col) = pk;
      }
    }
  }
}

DI void init_phase(const float* __restrict__ x, float* __restrict__ h, u16* __restrict__ hb, int wv_) {
  const size_t n4 = (size_t)M_TOK * DM / 4;
  for (size_t i = (size_t)lbid() * NTHREADS + ltid(); i < n4; i += (size_t)gridDim.x * NTHREADS) {
    float4 v = ((const float4*)x)[i];
    ((float4*)h)[i] = v;
    uint2 pk; pk.x = pack2(v.x, v.y); pk.y = pack2(v.z, v.w);
    ((uint2*)hb)[i] = pk;
  }
}

enum { EPI_FFN1 = 0, EPI_RES = 1, EPI_HYBIN = 2, EPI_NSAIN = 3, EPI_SILU = 4, EPI_PLAIN = 5 };
struct EpiArgs {
  u16* cb;
  int ldc;
  int nvalid;
  int mvalid;
  float* f0;
  float* f1;
  float scale;
  const float* lng;
  const float* lnb;
  const float* stats;
};
using f32x4 = __attribute__((ext_vector_type(4))) float;
constexpr int G_BM = 256, G_BK = 64, G_HALF = 128, G_HT = G_HALF * G_BK;
DI int lds_byte(int r, int c) {
  int st = (r >> 4) * 2 + (c >> 5), rr = r & 15, cc = c & 31, ob = rr * 64 + cc * 2;
  return st * 1024 + (ob ^ (((ob >> 9) & 1) << 5));
}
DI void stage_rc(int b, int& R, int& C) {
  int st = b / 1024, sb = b % 1024, swz = sb ^ (((sb >> 9) & 1) << 5);
  R = (st >> 1) * 16 + swz / 64; C = (st & 1) * 32 + (swz % 64) / 2;
}

template <int MODE>
DI void gemm_phase(const u16* __restrict__ A, int lda_unused, const u16* __restrict__ Bt, int Mrows, int Npad, int K, EpiArgs ea, char* smem, int wv_, int blk_off = 0) {
  u16* shm = (u16*)smem;
#define SA(b, h) (shm + ((b) * 2 + (h)) * G_HT)
#define SB(b, h) (shm + (4 + (b) * 2 + (h)) * G_HT)
#define STAGE(P, BASE, br, kt) do { const char* _g = ((br) == (BASE##row0)) ? c##BASE : c##BASE##h; const unsigned _ko = (unsigned)(kt) * (G_BK * 2u); \
    __builtin_amdgcn_global_load_lds((const unsigned*)(_g + (size_t)(so0 + _ko)), (unsigned*)((char*)(P) + sb0), 16, 0, 0); \
    __builtin_amdgcn_global_load_lds((const unsigned*)(_g + (size_t)(so1 + _ko)), (unsigned*)((char*)(P) + sb0 + 8192), 16, 0, 0); } while (0)
#define LDA(dst, b, h) _Pragma("unroll") for (int m = 0; m < 4; ++m) _Pragma("unroll") for (int k = 0; k < 2; ++k) \
    dst[m][k] = *reinterpret_cast<const bf16x8*>((char*)SA(b, h) + aoff + m * 2048 + k * 1024)
#define LDB(dst, b, h) _Pragma("unroll") for (int n = 0; n < 2; ++n) _Pragma("unroll") for (int k = 0; k < 2; ++k) \
    dst[n][k] = *reinterpret_cast<const bf16x8*>((char*)SB(b, h) + boff + n * 2048 + k * 1024)
#define MMA(ai, bj, At_, Bt_) do { __builtin_amdgcn_s_setprio(1); \
    _Pragma("unroll") for (int m = 0; m < 4; ++m) _Pragma("unroll") for (int n = 0; n < 2; ++n) _Pragma("unroll") for (int k = 0; k < 2; ++k) \
      acc[ai][bj][m][n] = __builtin_amdgcn_mfma_f32_16x16x32_bf16(Bt_[n][k], At_[m][k], acc[ai][bj][m][n], 0, 0, 0); \
    __builtin_amdgcn_s_setprio(0); } while (0)
#define WAIT_V(n) asm volatile("s_waitcnt vmcnt(" #n ")" ::: "memory")
#define WAIT_L(n) asm volatile("s_waitcnt lgkmcnt(" #n ")" ::: "memory")
#define BAR __builtin_amdgcn_s_barrier()
#define SCHED __builtin_amdgcn_sched_barrier(0)
  const int tid = ltid();
  const int wid = tid >> 6, lane = tid & 63, wr = wid >> 2, wc = wid & 3, fr = lane & 15, fq = lane >> 4;
  const int nM = Mrows / G_BM, nN = Npad / G_BM, nwg = nM * nN;
  const int sb0 = tid * 16;
  const int nt = K / G_BK;
  const int aoff = lds_byte(wr * 64 + fr, fq * 8), boff = lds_byte(wc * 32 + fr, fq * 8);
  int tile_first = lbid() - blk_off;
  if (tile_first < 0) tile_first += gridDim.x;
  for (int tile = tile_first; tile < nwg; tile += gridDim.x) {
    int wgid = tile;
    { int q = nwg / 8, r = nwg % 8, xcd = wgid % 8, off = wgid / 8;
      wgid = (xcd < r ? xcd * (q + 1) : r * (q + 1) + (xcd - r) * q) + off; }
    const int nig = 4 * nN, gid = wgid / nig, fm = gid * 4, gsz = min(nM - fm, 4);
    const int pm = fm + ((wgid % nig) % gsz), pn = (wgid % nig) / gsz, brow = pm * G_BM, bcol = pn * G_BM;
    const int Arow0 = brow, Btrow0 = bcol;
    const size_t kb2 = (size_t)K * 2;
    const char* cA = (const char*)A + (size_t)brow * kb2;
    const char* cBt = (const char*)Bt + (size_t)bcol * kb2;
    unsigned so0, so1;
    { const int tb = ltid() * 16; int r_, c_; stage_rc(tb, r_, c_); so0 = (unsigned)(r_ * K + c_) * 2u; stage_rc(tb + 8192, r_, c_); so1 = (unsigned)(r_ * K + c_) * 2u; }
    const char* cAh = cA + (size_t)G_HALF * kb2;
    const char* cBth = cBt + (size_t)G_HALF * kb2;
    asm volatile("" : "+s"(cA), "+s"(cBt), "+s"(cAh), "+s"(cBth), "+v"(so0), "+v"(so1));
    f32x4 acc[2][2][4][2];
#pragma unroll
    for (int a = 0; a < 2; ++a)
#pragma unroll
      for (int b = 0; b < 2; ++b)
#pragma unroll
        for (int m = 0; m < 4; ++m)
#pragma unroll
          for (int n = 0; n < 2; ++n) acc[a][b][m][n] = f32x4{0.f, 0.f, 0.f, 0.f};
    bf16x8 At[4][2], B0[2][2], B1[2][2];
    STAGE(SB(0, 0), Bt, bcol, 0); STAGE(SA(0, 0), A, brow, 0);
    STAGE(SB(0, 1), Bt, bcol + G_HALF, 0); STAGE(SA(0, 1), A, brow + G_HALF, 0);
    if (wr == 1) BAR;
    WAIT_V(4); BAR;
    STAGE(SB(1, 0), Bt, bcol, 1); STAGE(SA(1, 0), A, brow, 1); STAGE(SB(1, 1), Bt, bcol + G_HALF, 1);
    WAIT_V(6); BAR;
    for (int t = 0; t < nt - 2; t += 2) {
      LDB(B0, 0, 0); SCHED; LDA(At, 0, 0); STAGE(SA(1, 1), A, brow + G_HALF, t + 1);
      WAIT_L(8); BAR; WAIT_L(0); MMA(0, 0, At, B0); BAR; SCHED;
      LDB(B1, 0, 1); STAGE(SB(0, 0), Bt, bcol, t + 2);
      BAR; WAIT_L(0); MMA(0, 1, At, B1); BAR;
      LDA(At, 0, 1); STAGE(SA(0, 0), A, brow, t + 2);
      BAR; WAIT_L(0); MMA(1, 0, At, B0); BAR; SCHED;
      STAGE(SB(0, 1), Bt, bcol + G_HALF, t + 2);
      WAIT_V(6); BAR; MMA(1, 1, At, B1); BAR;
      LDB(B0, 1, 0); SCHED; LDA(At, 1, 0); STAGE(SA(0, 1), A, brow + G_HALF, t + 2);
      WAIT_L(8); BAR; WAIT_L(0); MMA(0, 0, At, B0); BAR; SCHED;
      LDB(B1, 1, 1); STAGE(SB(1, 0), Bt, bcol, t + 3);
      BAR; WAIT_L(0); MMA(0, 1, At, B1); BAR;
      LDA(At, 1, 1); STAGE(SA(1, 0), A, brow, t + 3);
      BAR; WAIT_L(0); MMA(1, 0, At, B0); BAR; SCHED;
      STAGE(SB(1, 1), Bt, bcol + G_HALF, t + 3);
      WAIT_V(6); BAR; MMA(1, 1, At, B1); BAR;
    }
    { LDB(B0, 0, 0); LDA(At, 0, 0); STAGE(SA(1, 1), A, brow + G_HALF, nt - 1);
      BAR; WAIT_L(0); MMA(0, 0, At, B0); BAR;
      LDB(B1, 0, 1); BAR; WAIT_L(0); MMA(0, 1, At, B1); BAR;
      LDA(At, 0, 1); WAIT_V(4); BAR; WAIT_L(0); MMA(1, 0, At, B0); MMA(1, 1, At, B1); BAR; }
    { LDB(B0, 1, 0); LDA(At, 1, 0); WAIT_V(2); BAR; WAIT_L(0); MMA(0, 0, At, B0); BAR;
      LDB(B1, 1, 1); WAIT_V(0); BAR; WAIT_L(0); MMA(0, 1, At, B1); BAR;
      LDA(At, 1, 1); BAR; WAIT_L(0); MMA(1, 0, At, B0); MMA(1, 1, At, B1); BAR; }
    if (wr == 0) BAR;
    { const int tid_e = ltid(); const int wid = tid_e >> 6, lane = tid_e & 63, wr = wid >> 2, wc = wid & 3, fr = lane & 15, fq = lane >> 4;
#pragma unroll
    for (int ai = 0; ai < 2; ++ai)
#pragma unroll
      for (int bj = 0; bj < 2; ++bj)
#pragma unroll
        for (int m = 0; m < 4; ++m) {
          __builtin_amdgcn_sched_barrier(0);
          const int row = brow + ai * G_HALF + wr * 64 + m * 16 + fr;
          const int colb = bcol + bj * G_HALF + wc * 32 + fq * 4;
          if (MODE == EPI_RES) {
            float* hp0 = ea.f0 + (size_t)row * DM + colb;
            float4 h0 = *(const float4*)hp0, h1 = *(const float4*)(hp0 + 16);
            if (ea.lng) {
              const float4 g0 = *(const float4*)(ea.lng + colb), g1 = *(const float4*)(ea.lng + colb + 16);
              const float4 b0 = *(const float4*)(ea.lnb + colb), b1 = *(const float4*)(ea.lnb + colb + 16);
              const float2 st = *(const float2*)(ea.stats + (size_t)row * 2);
              h0.x = (h0.x - st.x) * st.y * g0.x + b0.x; h0.y = (h0.y - st.x) * st.y * g0.y + b0.y;
              h0.z = (h0.z - st.x) * st.y * g0.z + b0.z; h0.w = (h0.w - st.x) * st.y * g0.w + b0.w;
              h1.x = (h1.x - st.x) * st.y * g1.x + b1.x; h1.y = (h1.y - st.x) * st.y * g1.y + b1.y;
              h1.z = (h1.z - st.x) * st.y * g1.z + b1.z; h1.w = (h1.w - st.x) * st.y * g1.w + b1.w;
            }
            const f32x4 a0 = acc[ai][bj][m][0], a1 = acc[ai][bj][m][1];
            float4 o0, o1;
            o0.x = ALPHA * h0.x + ea.scale * a0[0]; o0.y = ALPHA * h0.y + ea.scale * a0[1]; o0.z = ALPHA * h0.z + ea.scale * a0[2]; o0.w = ALPHA * h0.w + ea.scale * a0[3];
            o1.x = ALPHA * h1.x + ea.scale * a1[0]; o1.y = ALPHA * h1.y + ea.scale * a1[1]; o1.z = ALPHA * h1.z + ea.scale * a1[2]; o1.w = ALPHA * h1.w + ea.scale * a1[3];
            *(float4*)hp0 = o0; *(float4*)(hp0 + 16) = o1;
          } else if (MODE == EPI_FFN1) {
            const f32x4 gv = acc[ai][bj][m][0], uv = acc[ai][bj][m][1];
            const int jj = (bcol + bj * G_HALF + wc * 32) / 2 + fq * 4;
            uint2 pk;
            pk.x = pack2(silu_f(gv[0]) * uv[0], silu_f(gv[1]) * uv[1]);
            pk.y = pack2(silu_f(gv[2]) * uv[2], silu_f(gv[3]) * uv[3]);
            *(uint2*)(ea.cb + (size_t)row * DFF + jj) = pk;
          } else {
#pragma unroll
            for (int n = 0; n < 2; ++n) {
              const int col = colb + n * 16;
              const f32x4 v = acc[ai][bj][m][n];
              if (MODE == EPI_HYBIN) {
                if (col < HYB_IN_N) {
                  uint2 pk; pk.x = pack2(v[0], v[1]); pk.y = pack2(v[2], v[3]);
                  *(uint2*)(ea.cb + (size_t)row * HYB_IN_N + col) = pk;
                  if (col >= 3072 && col < 3088) *(float4*)(ea.f0 + (size_t)row * 16 + col - 3072) = make_float4(v[0], v[1], v[2], v[3]);
                  if (col >= 5648) *(float4*)(ea.f1 + (size_t)row * 16 + col - 5648) = make_float4(v[0], v[1], v[2], v[3]);
                }
              } else if (MODE == EPI_NSAIN) {
                if (col < NSA_IN_N) {
                  uint2 pk; pk.x = pack2(v[0], v[1]); pk.y = pack2(v[2], v[3]);
                  *(uint2*)(ea.cb + (size_t)row * NSA_IN_N + col) = pk;
                  if (col >= 1792) *(float4*)(ea.f0 + (size_t)row * 48 + col - 1792) = make_float4(sigmoid_acc(v[0]), sigmoid_acc(v[1]), sigmoid_acc(v[2]), sigmoid_acc(v[3]));
                }
              } else if (MODE == EPI_SILU) {
                uint2 pk; pk.x = pack2(silu_f(v[0]), silu_f(v[1])); pk.y = pack2(silu_f(v[2]), silu_f(v[3]));
                *(uint2*)(ea.cb + (size_t)row * ea.ldc + col) = pk;
              } else {
                if (col < ea.nvalid) { uint2 pk; pk.x = pack2(v[0], v[1]); pk.y = pack2(v[2], v[3]); *(uint2*)(ea.cb + (size_t)row * ea.ldc + col) = pk; }
              }
            }
          }
        }
    }
    WAIT_V(0);
    __syncthreads();
  }
#undef SA
#undef SB
#undef STAGE
#undef LDA
#undef LDB
#undef MMA
}

DI void hyb_prep(const Params p, int li) {
  const int wv_ = p.wave;
  const u16* __restrict__ proj = (const u16*)(p.ws + OFF_PROJ);
  const float* __restrict__ glog = (const float*)(p.ws + OFF_GLOG);
  const float* __restrict__ sdtl = (const float*)(p.ws + OFF_SDTL);
  u16* __restrict__ GQ = (u16*)(p.ws + OFF_GQ); u16* __restrict__ GK = (u16*)(p.ws + OFF_GK); u16* __restrict__ GV = (u16*)(p.ws + OFF_GV);
  float* __restrict__ GA = (float*)(p.ws + OFF_GA); float* __restrict__ GB = (float*)(p.ws + OFF_GB);
  u16* __restrict__ SX = (u16*)(p.ws + OFF_SX); u16* __restrict__ SB = (u16*)(p.ws + OFF_SB); u16* __restrict__ SC = (u16*)(p.ws + OFF_SC);
  float* __restrict__ SDT = (float*)(p.ws + OFF_SDT); float* __restrict__ SDA = (float*)(p.ws + OFF_SDA);
  const float* gcw = p.gdn_conv_w + (size_t)li * 4 * 2048;
  const float* scw = p.ssd_conv_w + (size_t)li * 4 * 1536;
  const float* scb = p.ssd_conv_b + (size_t)li * 1536;
  const int lane = ltid() & 63;
  XCD_AFF_DECL;
  const int wave = xa_on ? xa_slot : ((lbid() * NTHREADS + ltid()) >> 6), nw = xa_on ? xa_wpx : (int)gridDim.x * (NTHREADS / 64);
  const int rbase = xa_on ? xa_x * (M_TOK / 32) : 0, rcnt = xa_on ? M_TOK / 32 : M_TOK / 4;
  for (int rr = wave; rr < rcnt; rr += nw) {
    const int tb = rbase + rr;
    const int tok0 = tb * 4;
    const int t0 = tok0 & (T_SEQ - 1);
#pragma unroll 2
    for (int grp = 0; grp < 28; ++grp) {
      const bool isg = grp < 16;
      const int ch = (isg ? grp : grp - 16) * 128 + lane * 2;
      const int col = (isg ? 0 : 4112) + ch;
      const float* cw = isg ? gcw : scw;
      const int C = isg ? 2048 : 1536;
      unsigned xr[7];
#pragma unroll
      for (int r = 0; r < 7; ++r) {
        xr[r] = 0u;
        if (t0 - 3 + r >= 0) xr[r] = *(const unsigned*)(proj + (size_t)(tok0 - 3 + r) * HYB_IN_N + col);
      }
      float2 wv[4];
#pragma unroll
      for (int j = 0; j < 4; ++j) wv[j] = *(const float2*)(cw + j * C + ch);
      float b0 = 0.f, b1 = 0.f;
      if (!isg) { b0 = scb[ch]; b1 = scb[ch + 1]; }
      float y0[4], y1[4];
#pragma unroll
      for (int o = 0; o < 4; ++o) {
        float a0 = b0, a1 = b1;
#pragma unroll
        for (int j = 0; j < 4; ++j) { a0 += wv[j].x * bf2f((u16)(xr[o + j] & 0xffff)); a1 += wv[j].y * bf2f((u16)(xr[o + j] >> 16)); }
        y0[o] = silu_f(a0); y1[o] = silu_f(a1);
      }
      if (grp < 8) {
#pragma unroll
        for (int o = 0; o < 4; ++o) {
          float ss = wave_sum(y0[o] * y0[o] + y1[o] * y1[o]);
          float r = rsqrtf(ss + 1e-6f);
          if (grp < 4) r *= 0.08838834764831845f;
          u16* dst = (grp < 4 ? GQ : GK) + (size_t)(tok0 + o) * 512 + (grp & 3) * 128 + lane * 2;
          *(unsigned*)dst = pack2(y0[o] * r, y1[o] * r);
        }
      } else if (grp < 16) {
#pragma unroll
        for (int o = 0; o < 4; ++o) *(unsigned*)(GV + (size_t)(tok0 + o) * 1024 + (grp - 8) * 128 + lane * 2) = pack2(y0[o], y1[o]);
      } else {
#pragma unroll
        for (int o = 0; o < 4; ++o) {
          const size_t tk = tok0 + o;
          if (ch < 1024) *(unsigned*)(SX + tk * 1024 + ch) = pack2(y0[o], y1[o]);
          else if (ch < 1280) *(unsigned*)(SB + tk * 256 + ch - 1024) = pack2(y0[o], y1[o]);
          else *(unsigned*)(SC + tk * 256 + ch - 1280) = pack2(y0[o], y1[o]);
        }
      }
    }
    if (lane < 32) {
      const int o = lane >> 3, hd = lane & 7;
      const size_t tk = tok0 + o;
      float bl = glog[tk * 16 + hd], al_ = glog[tk * 16 + 8 + hd];
      GB[tk * 8 + hd] = sigmoid_acc(bl);
      float g = -expf(p.gdn_a_log[li * 8 + hd]) * softplus_acc(al_ + p.gdn_dt_bias[li * 8 + hd]);
      GA[tk * 8 + hd] = expf(g);
    }
    {
      const int o = lane >> 4, hd = lane & 15;
      const size_t tk = tok0 + o;
      float dt = softplus_acc(sdtl[tk * 16 + hd] + p.ssd_dt_bias[li * 16 + hd]);
      SDT[tk * 16 + hd] = dt;
      SDA[tk * 16 + hd] = expf(-expf(p.ssd_a_log[li * 16 + hd]) * dt);
    }
  }
}

DI void scan_item(const Params p, int li, int item, char* smem) {
  const int wv_ = p.wave;
  const int b = item >> 5, hv = (item >> 2) & 7, sl = item & 3, kh = hv >> 1;
  const int hd = (item >> 1) & 15, half = item & 1, sg = hd >> 3;
  const u16* GQ = (const u16*)(p.ws + OFF_GQ); const u16* GK = (const u16*)(p.ws + OFF_GK);
  u16* GV = (u16*)(p.ws + OFF_GV);
  const float* GA = (const float*)(p.ws + OFF_GA); const float* GB = (const float*)(p.ws + OFF_GB);
  u16* SX = (u16*)(p.ws + OFF_SX);
  const u16* SBg = (const u16*)(p.ws + OFF_SB); const u16* SCg = (const u16*)(p.ws + OFF_SC);
  const float* SDT = (const float*)(p.ws + OFF_SDT); const float* SDA = (const float*)(p.ws + OFF_SDA);
  const float dsk = p.ssd_d[li * 16 + hd];
  float* sk = (float*)smem;
  float* sq = sk + 32 * 192;
  float* sBm = sq + 32 * 192;
  float* sCm = sBm + 32 * 192;
  float* sv = sCm + 32 * 192;
  float* sx = sv + 32 * 32;
  float* sa = sx + 32 * 32;
  float* so_ = sa + 128;
  float* sy_ = so_ + 32 * 32;
  const int tid = ltid(), lane = tid & 63, w = tid >> 6;
  const int c = lane >> 4, ks = lane & 15, col = w * 4 + c;
  v2f S2[4], H2[4];
#pragma unroll
  for (int i = 0; i < 4; ++i) { S2[i] = v2f{0.f, 0.f}; H2[i] = v2f{0.f, 0.f}; }
  float4 rk0, rk1, rq0, rq1, rb0, rb1, rc0, rc1, rvx;
  float rs0 = 0.f, rs1 = 0.f;
  const int st_tk0 = tid >> 5, st_f4 = tid & 31;
  const int t2 = tid & 255, st_tk = t2 >> 3, st_f = t2 & 7;
#define SCAN_LOAD(chunk_) do { const size_t tok0_ = (size_t)b * T_SEQ + (chunk_) * 32; \
      rk0 = ld4bf(GK + (tok0_ + st_tk0) * 512 + kh * 128 + st_f4 * 4); \
      rq0 = ld4bf(GQ + (tok0_ + st_tk0) * 512 + kh * 128 + st_f4 * 4); \
      rb0 = ld4bf(SBg + (tok0_ + st_tk0) * 256 + sg * 128 + st_f4 * 4); \
      rc0 = ld4bf(SCg + (tok0_ + st_tk0) * 256 + sg * 128 + st_f4 * 4); \
      rk1 = ld4bf(GK + (tok0_ + st_tk0 + 16) * 512 + kh * 128 + st_f4 * 4); \
      rq1 = ld4bf(GQ + (tok0_ + st_tk0 + 16) * 512 + kh * 128 + st_f4 * 4); \
      rb1 = ld4bf(SBg + (tok0_ + st_tk0 + 16) * 256 + sg * 128 + st_f4 * 4); \
      rc1 = ld4bf(SCg + (tok0_ + st_tk0 + 16) * 256 + sg * 128 + st_f4 * 4); \
    if (tid < 256) rvx = ld4bf(GV + (tok0_ + st_tk) * 1024 + hv * 128 + sl * 32 + st_f * 4); \
    else rvx = ld4bf(SX + (tok0_ + st_tk) * 1024 + hd * 64 + half * 32 + st_f * 4); \
    if (tid < 32) { rs0 = GA[(tok0_ + tid) * 8 + hv]; rs1 = GB[(tok0_ + tid) * 8 + hv]; } \
    else if (tid < 64) { rs0 = SDT[(tok0_ + tid - 32) * 16 + hd]; rs1 = SDA[(tok0_ + tid - 32) * 16 + hd]; } } while (0)
  SCAN_LOAD(0);
  for (int chunk = 0; chunk < T_SEQ / 32; ++chunk) {
    const size_t tok0 = (size_t)b * T_SEQ + chunk * 32;
    __syncthreads();
    {
      const int lo = st_tk0 * 192 + (st_f4 >> 1) * 12 + (st_f4 & 1) * 4;
      *(float4*)(sk + lo) = rk0; *(float4*)(sq + lo) = rq0; *(float4*)(sBm + lo) = rb0; *(float4*)(sCm + lo) = rc0;
      *(float4*)(sk + lo + 16 * 192) = rk1; *(float4*)(sq + lo + 16 * 192) = rq1; *(float4*)(sBm + lo + 16 * 192) = rb1; *(float4*)(sCm + lo + 16 * 192) = rc1;
    }
    if (tid < 256) *(float4*)(sv + st_tk * 32 + st_f * 4) = rvx; else *(float4*)(sx + st_tk * 32 + st_f * 4) = rvx;
    if (tid < 32) { sa[tid] = rs0; sa[32 + tid] = rs1; }
    else if (tid < 64) { sa[64 + tid - 32] = rs0; sa[96 + tid - 32] = rs1; }
    __syncthreads();
    if (chunk + 1 < T_SEQ / 32) SCAN_LOAD(chunk + 1);
    const float* pk = sk + ks * 12; const float* pq = sq + ks * 12; const float* pb = sBm + ks * 12; const float* pc = sCm + ks * 12;
    float4 nk0 = *(const float4*)(pk), nk1 = *(const float4*)(pk + 4), nq0 = *(const float4*)(pq), nq1 = *(const float4*)(pq + 4);
    float4 nb0 = *(const float4*)(pb), nb1 = *(const float4*)(pb + 4), nc0 = *(const float4*)(pc), nc1 = *(const float4*)(pc + 4);
    float na = sa[0], nbt = sa[32], ndt = sa[64], nda = sa[96], nv = sv[col], nx = sx[col];
#pragma unroll 2
    for (int tt = 0; tt < 32; ++tt) {
      const float4 k0 = nk0, k1 = nk1, q0 = nq0, q1 = nq1, b0 = nb0, b1 = nb1, c0 = nc0, c1 = nc1;
      const float a = na, bt = nbt, dt = ndt, da = nda, v = nv, xv = nx;
      if (tt + 1 < 32) {
        const int o = (tt + 1) * 192;
        nk0 = *(const float4*)(pk + o); nk1 = *(const float4*)(pk + o + 4); nq0 = *(const float4*)(pq + o); nq1 = *(const float4*)(pq + o + 4);
        nb0 = *(const float4*)(pb + o); nb1 = *(const float4*)(pb + o + 4); nc0 = *(const float4*)(pc + o); nc1 = *(const float4*)(pc + o + 4);
        na = sa[tt + 1]; nbt = sa[33 + tt]; ndt = sa[65 + tt]; nda = sa[97 + tt]; nv = sv[(tt + 1) * 32 + col]; nx = sx[(tt + 1) * 32 + col];
      }
      const v2f kk0 = {k0.x, k0.y}, kk1 = {k0.z, k0.w}, kk2 = {k1.x, k1.y}, kk3 = {k1.z, k1.w};
      const v2f qa0 = {q0.x, q0.y}, qa1 = {q0.z, q0.w}, qa2 = {q1.x, q1.y}, qa3 = {q1.z, q1.w};
      v2f dacc = S2[0] * kk0; dacc = S2[1] * kk1 + dacc; dacc = S2[2] * kk2 + dacc; dacc = S2[3] * kk3 + dacc;
      const float dot = red16(dacc.x + dacc.y);
      const float d = bt * (v - a * dot);
      const v2f dd = {d, d}, aa = {a, a};
      S2[0] = aa * S2[0] + kk0 * dd; S2[1] = aa * S2[1] + kk1 * dd; S2[2] = aa * S2[2] + kk2 * dd; S2[3] = aa * S2[3] + kk3 * dd;
      v2f oacc = S2[0] * qa0; oacc = S2[1] * qa1 + oacc; oacc = S2[2] * qa2 + oacc; oacc = S2[3] * qa3 + oacc;
      const float o = red16(oacc.x + oacc.y);
      const float xdt = xv * dt;
      const v2f xx = {xdt, xdt}, dda = {da, da};
      const v2f bb0 = {b0.x, b0.y}, bb1 = {b0.z, b0.w}, bb2 = {b1.x, b1.y}, bb3 = {b1.z, b1.w};
      const v2f cc0 = {c0.x, c0.y}, cc1 = {c0.z, c0.w}, cc2 = {c1.x, c1.y}, cc3 = {c1.z, c1.w};
      H2[0] = H2[0] * dda + xx * bb0; H2[1] = H2[1] * dda + xx * bb1; H2[2] = H2[2] * dda + xx * bb2; H2[3] = H2[3] * dda + xx * bb3;
      v2f yacc = H2[0] * cc0; yacc = H2[1] * cc1 + yacc; yacc = H2[2] * cc2 + yacc; yacc = H2[3] * cc3 + yacc;
      const float y = red16(yacc.x + yacc.y);
      if (ks == 0) { so_[tt * 32 + col] = o; sy_[tt * 32 + col] = y + dsk * xv; }
    }
    __syncthreads();
    {
      const int t2 = tid & 255, tk = t2 >> 3, f4 = t2 & 7;
      if (tid < 256) st4bf(GV + (tok0 + tk) * 1024 + hv * 128 + sl * 32 + f4 * 4, *(const float4*)(so_ + tk * 32 + f4 * 4));
      else st4bf(SX + (tok0 + tk) * 1024 + hd * 64 + half * 32 + f4 * 4, *(const float4*)(sy_ + tk * 32 + f4 * 4));
    }
  }
}

DI void hyb_post(const Params p, int li) {
  const int wv_ = p.wave;
  const u16* __restrict__ proj = (const u16*)(p.ws + OFF_PROJ);
  const u16* __restrict__ GV = (const u16*)(p.ws + OFF_GV);
  const u16* __restrict__ SX = (const u16*)(p.ws + OFF_SX);
  u16* __restrict__ O = (u16*)(p.ws + OFF_O);
  const float* gnw = p.gdn_norm_w + li * 128;
  const float* snw = p.ssd_norm_w + li * 1024;
  const int lane = ltid() & 63;
  XCD_AFF_DECL;
  const int wave = xa_on ? xa_slot : ((lbid() * NTHREADS + ltid()) >> 6), nw = xa_on ? xa_wpx : (int)gridDim.x * (NTHREADS / 64);
  const int rbase = xa_on ? xa_x * (M_TOK / 8) : 0, rcnt = xa_on ? M_TOK / 8 : M_TOK;
  for (int rr = wave; rr < rcnt; rr += nw) {
    const int tok = rbase + rr;
    float2 ov[8]; unsigned zg[8];
#pragma unroll
    for (int hv = 0; hv < 8; ++hv) {
      { const unsigned u_ = *(const unsigned*)(GV + (size_t)tok * 1024 + hv * 128 + lane * 2); ov[hv] = make_float2(__uint_as_float(u_ << 16), __uint_as_float(u_ & 0xffff0000u)); }
      zg[hv] = *(const unsigned*)(proj + (size_t)tok * HYB_IN_N + 2048 + hv * 128 + lane * 2);
    }
    float4 ya[2], yb[2]; uint4 zs[2];
#pragma unroll
    for (int grp = 0; grp < 2; ++grp) {
      const int ch = grp * 512 + lane * 8;
      ya[grp] = ld4bf(SX + (size_t)tok * 1024 + ch);
      yb[grp] = ld4bf(SX + (size_t)tok * 1024 + ch + 4);
      zs[grp] = *(const uint4*)(proj + (size_t)tok * HYB_IN_N + 3088 + ch);
    }
    const float2 nwv = *(const float2*)(gnw + lane * 2);
#pragma unroll
    for (int hv = 0; hv < 8; ++hv) {
      const float2 o = ov[hv];
      float ss = wave_sum(o.x * o.x + o.y * o.y);
      float r = rsqrtf(ss * (1.f / 128.f) + 1e-6f);
      float z0 = bf2f((u16)(zg[hv] & 0xffff)), z1 = bf2f((u16)(zg[hv] >> 16));
      *(unsigned*)(O + (size_t)tok * 2048 + hv * 128 + lane * 2) = pack2(o.x * r * nwv.x * silu_f(z0), o.y * r * nwv.y * silu_f(z1));
    }
#pragma unroll
    for (int grp = 0; grp < 2; ++grp) {
      const int ch = grp * 512 + lane * 8;
      float yy[8] = {ya[grp].x, ya[grp].y, ya[grp].z, ya[grp].w, yb[grp].x, yb[grp].y, yb[grp].z, yb[grp].w};
      unsigned zz[4] = {zs[grp].x, zs[grp].y, zs[grp].z, zs[grp].w};
      float ss = 0.f;
#pragma unroll
      for (int j = 0; j < 8; ++j) {
        float z = bf2f((u16)((zz[j >> 1] >> ((j & 1) * 16)) & 0xffff));
        yy[j] *= silu_f(z); ss += yy[j] * yy[j];
      }
      ss = wave_sum(ss);
      float r = rsqrtf(ss * (1.f / 512.f) + 1e-6f);
      float4 w0 = *(const float4*)(snw + ch), w1 = *(const float4*)(snw + ch + 4);
      uint4 ovv;
      ovv.x = pack2(yy[0] * r * w0.x, yy[1] * r * w0.y); ovv.y = pack2(yy[2] * r * w0.z, yy[3] * r * w0.w);
      ovv.z = pack2(yy[4] * r * w1.x, yy[5] * r * w1.y); ovv.w = pack2(yy[6] * r * w1.z, yy[7] * r * w1.w);
      *(uint4*)(O + (size_t)tok * 2048 + 1024 + ch) = ovv;
    }
  }
}

DI void nsa_prep(const Params p, int li) {
  const int wv_ = p.wave;
  const u16* __restrict__ proj = (const u16*)(p.ws + OFF_PROJ);
  u16* __restrict__ QROT = (u16*)(p.ws + OFF_QROT); u16* __restrict__ KSR = (u16*)(p.ws + OFF_KSR); u16* __restrict__ KWR = (u16*)(p.ws + OFF_KWR);
  u16* __restrict__ FLATK = (u16*)(p.ws + OFF_FLATK); u16* __restrict__ FLATV = (u16*)(p.ws + OFF_FLATV);
  const float* cpos = p.nsa_cmp_pos + (size_t)li * 2 * 32 * 64;
  const float INVF[8] = {1.0f, 0.1939227432012558f, 0.03760603070259094f, 0.007292664609849453f, 0.0014142135623842478f,
                         0.00027424818836152554f, 5.3182957344688475e-05f, 1.0313385246263351e-05f};
  const int lane = ltid() & 63;
  XCD_AFF_DECL;
  const int wave = xa_on ? xa_slot : ((lbid() * NTHREADS + ltid()) >> 6), nw = xa_on ? xa_wpx : (int)gridDim.x * (NTHREADS / 64);
  const int rbase = xa_on ? xa_x * (M_TOK / 8) : 0, rcnt = xa_on ? M_TOK / 8 : M_TOK;
  for (int rr = wave; rr < rcnt; rr += nw) {
    const int tok = rbase + rr;
    const int t = tok & (T_SEQ - 1), b = tok >> 11;
    const float pf = (float)p.pos[tok];
    const int fi = lane & 7;
    float invf = INVF[0];
#pragma unroll
    for (int i = 1; i < 8; ++i) if (fi == i) invf = INVF[i];
    float sn, cs;
    sincosf(pf * invf, &sn, &cs);
    const u16* pr = proj + (size_t)tok * NSA_IN_N;
#pragma unroll
    for (int r = 0; r < 2; ++r) {
      const int pi = lane + 64 * r, hd = pi >> 3;
      float x1 = bf2f(pr[hd * 64 + fi]), x2 = bf2f(pr[hd * 64 + 8 + fi]);
      QROT[((size_t)tok * 16 + hd) * 16 + fi] = f2bf(x1 * cs - x2 * sn);
      QROT[((size_t)tok * 16 + hd) * 16 + 8 + fi] = f2bf(x2 * cs + x1 * sn);
    }
#pragma unroll
    for (int r = 0; r < 2; ++r) {
      const int cbase = r == 0 ? 1280 : 1536;
      u16* dst = (r == 0 ? KSR : KWR) + (size_t)tok * 128;
      if (lane < 16) {
        const int gg = lane >> 3;
        float x1 = bf2f(pr[cbase + gg * 64 + fi]), x2 = bf2f(pr[cbase + gg * 64 + 8 + fi]);
        dst[gg * 64 + fi] = f2bf(x1 * cs - x2 * sn);
        dst[gg * 64 + 8 + fi] = f2bf(x2 * cs + x1 * sn);
      }
      for (int e = lane; e < 96; e += 64) {
        const int gg = e / 48, d = 16 + e % 48;
        dst[gg * 64 + d] = pr[cbase + gg * 64 + d];
      }
    }
    {
      const int gg = lane >> 5, d = (lane & 31) * 2;
      unsigned kv = *(const unsigned*)(pr + 1024 + gg * 64 + d);
      unsigned vv = *(const unsigned*)(pr + 1152 + gg * 64 + d);
      const float k0 = bf2f((u16)(kv & 0xffff)), k1 = bf2f((u16)(kv >> 16));
      const float v0 = bf2f((u16)(vv & 0xffff)), v1 = bf2f((u16)(vv >> 16));
#pragma unroll
      for (int r = 0; r < 2; ++r) {
        const int c = (t >> 4) - 1 + r;
        const int j = t - 16 * c;
        if (c >= 0 && c < 127) {
          const size_t row = ((size_t)b * 127 + c) * 2 + gg;
          float2 pk = *(const float2*)(cpos + (0 * 32 + j) * 64 + d);
          float2 pv = *(const float2*)(cpos + (1 * 32 + j) * 64 + d);
          *(unsigned*)(FLATK + row * 2048 + j * 64 + d) = pack2(k0 + pk.x, k1 + pk.y);
          *(unsigned*)(FLATV + row * 2048 + j * 64 + d) = pack2(v0 + pv.x, v1 + pv.y);
        }
      }
    }
  }
}

using u32x4 = __attribute__((ext_vector_type(4))) unsigned;
DI bf16x8 pack8(const f32x16& x, int s2) {
  u32x4 r;
#pragma unroll
  for (int j = 0; j < 4; ++j) r[j] = pack2(x[8 * s2 + 2 * j], x[8 * s2 + 2 * j + 1]);
  return __builtin_bit_cast(bf16x8, r);
}

DI void nsa_attn_item(const Params p, int item, int flip, char* smem) {
  const int wv_ = p.wave;
  const int tile0 = item & 63, g = (item >> 6) & 1, b = item >> 7;
  const int tile = flip ? 63 - tile0 : tile0;
  const int t0 = tile * 32, cur = t0 >> 6;
  const u16* proj = (const u16*)(p.ws + OFF_PROJ);
  const float* GATES = (const float*)(p.ws + OFF_NGATE);
  const u16* QROT = (const u16*)(p.ws + OFF_QROT);
  const u16* KSR = (const u16*)(p.ws + OFF_KSR); const u16* KWR = (const u16*)(p.ws + OFF_KWR);
  const u16* KCMP = (const u16*)(p.ws + OFF_KCMP); const u16* VCMP = (const u16*)(p.ws + OFF_VCMP);
  u16* NO = (u16*)(p.ws + OFF_NO);
  u16* sK = (u16*)smem;
  u16* sVt = sK + 128 * 72;
  float* simp = (float*)(sVt + 64 * 136);
  unsigned* smask = (unsigned*)(simp + 32 * 33);
  const int tid = ltid(), lane = tid & 63, w = tid >> 6;
  const int l31 = lane & 31, hh = lane >> 5;
  const int tq = t0 + l31;
  const size_t tokq = (size_t)b * T_SEQ + tq;
  const float NEG_INF = -__builtin_huge_valf();
  const float SM_C = 0.125f * 1.4426950408889634f;
  const int head = g * 8 + w;

  __syncthreads();
  for (int i = tid; i < 32 * 33; i += NTHREADS) simp[i] = 0.f;
#pragma unroll
  for (int i = 0; i < 2; ++i) {
    {
      const int idx = tid + 512 * i, r = idx >> 3, c = idx & 7;
      uint4 kv = make_uint4(0, 0, 0, 0);
      if (r < 127) kv = *(const uint4*)(KCMP + (((size_t)b * 127 + r) * 2 + g) * 64 + c * 8);
      *(uint4*)(sK + r * 72 + c * 8) = kv;
    }
    {
      const int r = (tid & 63) + 64 * i, c = tid >> 6;
      uint4 vv = make_uint4(0, 0, 0, 0);
      if (r < 127) vv = *(const uint4*)(VCMP + (((size_t)b * 127 + r) * 2 + g) * 64 + c * 8);
      const unsigned vw[4] = {vv.x, vv.y, vv.z, vv.w};
#pragma unroll
      for (int j = 0; j < 8; ++j) sVt[(c * 8 + j) * 136 + r] = (u16)((vw[j >> 1] >> ((j & 1) * 16)) & 0xffff);
    }
  }
  __syncthreads();

  f32x16 otot[2];
  {
    bf16x8 qf[4];
#pragma unroll
    for (int ks = 0; ks < 4; ++ks) qf[ks] = *(const bf16x8*)(proj + tokq * NSA_IN_N + head * 64 + ks * 16 + hh * 8);
    const int cmax = (tq >= 31) ? ((tq - 31) >> 4) : -1;
    f32x16 s[4];
#pragma unroll
    for (int kt = 0; kt < 4; ++kt) {
#pragma unroll
      for (int i = 0; i < 16; ++i) s[kt][i] = 0.f;
#pragma unroll
      for (int ks = 0; ks < 4; ++ks) {
        bf16x8 a = *(const bf16x8*)(sK + (kt * 32 + l31) * 72 + ks * 16 + hh * 8);
        s[kt] = MFMA32(a, qf[ks], s[kt]);
      }
    }
    float mx = NEG_INF;
#pragma unroll
    for (int kt = 0; kt < 4; ++kt)
#pragma unroll
      for (int i = 0; i < 16; ++i) {
        const int c = kt * 32 + crow(i, hh);
        const float v = (c <= cmax) ? s[kt][i] : NEG_INF;
        s[kt][i] = v; mx = fmaxf(mx, v);
      }
    mx = fmaxf(mx, swap32(mx, lane)) * SM_C;
    const float msafe = (mx == NEG_INF) ? 0.f : mx;
    float sum = 0.f;
#pragma unroll
    for (int kt = 0; kt < 4; ++kt)
#pragma unroll
      for (int i = 0; i < 16; ++i) { const float e = __builtin_amdgcn_exp2f(__builtin_fmaf(s[kt][i], SM_C, -msafe)); s[kt][i] = e; sum += e; }
    sum += swap32(sum, lane);
    const float inv = 1.f / fmaxf(sum, 1e-30f);
#pragma unroll
    for (int kt = 0; kt < 4; ++kt)
#pragma unroll
      for (int i = 0; i < 16; ++i) s[kt][i] *= inv;
#pragma unroll
    for (int kt = 0; kt < 4; ++kt)
#pragma unroll
      for (int g4 = 0; g4 < 4; ++g4) {
        const int blk = 8 * kt + 2 * g4 + hh;
        const float p3 = s[kt][4 * g4 + 3];
        atomicAdd(&simp[l31 * 33 + blk], s[kt][4 * g4] + s[kt][4 * g4 + 1] + s[kt][4 * g4 + 2] + 0.5f * p3);
        if (blk + 1 < 32) atomicAdd(&simp[l31 * 33 + blk + 1], 0.5f * p3);
      }
    f32x16 oc[2];
#pragma unroll
    for (int dt = 0; dt < 2; ++dt)
#pragma unroll
      for (int i = 0; i < 16; ++i) oc[dt][i] = 0.f;
#pragma unroll
    for (int kt = 0; kt < 4; ++kt)
#pragma unroll
      for (int s2 = 0; s2 < 2; ++s2) {
        const bf16x8 pf = pack8(s[kt], s2);
#pragma unroll
        for (int dt = 0; dt < 2; ++dt) {
          const u16* vp = sVt + (dt * 32 + l31) * 136 + kt * 32 + 16 * s2 + 4 * hh;
          s16x4 lo = *(const s16x4*)vp, hi = *(const s16x4*)(vp + 8);
          bf16x8 vf = __builtin_shufflevector(lo, hi, 0, 1, 2, 3, 4, 5, 6, 7);
          oc[dt] = MFMA32(vf, pf, oc[dt]);
        }
      }
    const float gate = GATES[tokq * 48 + head * 3 + 0];
#pragma unroll
    for (int dt = 0; dt < 2; ++dt)
#pragma unroll
      for (int i = 0; i < 16; ++i) otot[dt][i] = gate * oc[dt][i];
  }
  __syncthreads();
  {
    const int tkn = tid >> 4, l16 = tid & 15;
    float sc0, sc1;
    {
      const int j0 = l16, j1 = l16 + 16;
      const bool c0 = j0 <= cur, c1 = j1 <= cur;
      const bool f0 = (j0 == 0) || (c0 && j0 > cur - 2), f1 = c1 && j1 > cur - 2;
      sc0 = f0 ? 1e4f : (c0 ? simp[tkn * 33 + j0] : -1.f);
      sc1 = f1 ? 1e4f : (c1 ? simp[tkn * 33 + j1] : -1.f);
    }
    unsigned sel = 0;
#pragma unroll 1
    for (int r = 0; r < 8; ++r) {
      float bv; int bj;
      if (sc0 >= sc1) { bv = sc0; bj = l16; } else { bv = sc1; bj = l16 + 16; }
#define TOPK_STEP(ctrl) { const float ov = __int_as_float(__builtin_amdgcn_update_dpp(0, __float_as_int(bv), (ctrl), 0xF, 0xF, false)); \
        const int oj = __builtin_amdgcn_update_dpp(0, bj, (ctrl), 0xF, 0xF, false); \
        if (ov > bv || (ov == bv && oj < bj)) { bv = ov; bj = oj; } }
      TOPK_STEP(0xB1) TOPK_STEP(0x4E) TOPK_STEP(0x141) TOPK_STEP(0x140)
      sel |= 1u << bj;
      if (bj == l16) sc0 = NEG_INF;
      if (bj == l16 + 16) sc1 = NEG_INF;
    }
    if (cur < 31) sel &= (1u << (cur + 1)) - 1u;
    if (l16 == 0) smask[tkn] = sel;
  }
  __syncthreads();
  const unsigned mymask = smask[l31];
  unsigned uni = 0;
  for (int i = 0; i < 32; ++i) uni |= smask[i];

  bf16x8 qq[4];
  qq[0] = *(const bf16x8*)(QROT + (tokq * 16 + head) * 16 + hh * 8);
#pragma unroll
  for (int ks = 1; ks < 4; ++ks) qq[ks] = *(const bf16x8*)(proj + tokq * NSA_IN_N + head * 64 + ks * 16 + hh * 8);
  {
    const int jlo = (t0 - 511 > 0 ? t0 - 511 : 0) >> 6;
    const int nsel = __popc(uni), ntile = nsel + (cur - jlo + 1);
    unsigned rem = uni;
    float mrun = NEG_INF, lrun = 0.f;
    f32x16 oa[2];
#pragma unroll
    for (int dt = 0; dt < 2; ++dt)
#pragma unroll
      for (int i = 0; i < 16; ++i) oa[dt][i] = 0.f;
    const int kr = tid >> 3, kc = tid & 7, vr = tid & 63, vc = tid >> 6;
    uint4 pk, pv;
    int nj, nbr;
    { nj = __ffs(rem) - 1; rem &= rem - 1; nbr = 0;
      pk = *(const uint4*)(KSR + (((size_t)b * T_SEQ + nj * 64 + kr) * 2 + g) * 64 + kc * 8);
      pv = *(const uint4*)(proj + ((size_t)b * T_SEQ + nj * 64 + vr) * NSA_IN_N + 1408 + g * 64 + vc * 8); }
#pragma unroll 1
    for (int it = 0; it < ntile; ++it) {
      const int j = nj, br = nbr;
      __syncthreads();
      *(uint4*)(sK + kr * 72 + kc * 8) = pk;
      {
        const unsigned vw[4] = {pv.x, pv.y, pv.z, pv.w};
#pragma unroll
        for (int jj = 0; jj < 8; ++jj) sVt[(vc * 8 + jj) * 136 + vr] = (u16)((vw[jj >> 1] >> ((jj & 1) * 16)) & 0xffff);
      }
      __syncthreads();
      if (it + 1 < ntile) {
        if (it + 1 < nsel) { nj = __ffs(rem) - 1; rem &= rem - 1; nbr = 0; } else { nj = jlo + it + 1 - nsel; nbr = 1; }
        const u16* Kg = nbr ? KWR : KSR;
        const int vcol = nbr ? 1664 : 1408;
        pk = *(const uint4*)(Kg + (((size_t)b * T_SEQ + nj * 64 + kr) * 2 + g) * 64 + kc * 8);
        pv = *(const uint4*)(proj + ((size_t)b * T_SEQ + nj * 64 + vr) * NSA_IN_N + vcol + g * 64 + vc * 8);
      }
      if (it == nsel) {
        const float gate = GATES[tokq * 48 + head * 3 + 1];
        const float sc = gate / fmaxf(lrun, 1e-30f);
#pragma unroll
        for (int dt = 0; dt < 2; ++dt)
#pragma unroll
          for (int i = 0; i < 16; ++i) { otot[dt][i] += sc * oa[dt][i]; oa[dt][i] = 0.f; }
        mrun = NEG_INF; lrun = 0.f;
      }
      f32x16 s[2];
#pragma unroll
      for (int kt = 0; kt < 2; ++kt) {
#pragma unroll
        for (int i = 0; i < 16; ++i) s[kt][i] = 0.f;
        const u16* kp = sK + (kt * 32 + l31) * 72 + hh * 8;
#pragma unroll
        for (int ks = 0; ks < 4; ++ks) s[kt] = MFMA32(*(const bf16x8*)(kp + ks * 16), qq[ks], s[kt]);
      }
      const bool selbit = (mymask >> j) & 1u;
      const int klo = br ? tq - 512 : -1;
      const bool rowok = br ? true : selbit;
      float mx = NEG_INF;
      const bool fullvis = (j * 64 + 63 <= t0) && (br == 0 || j * 64 > t0 + 31 - 512);
      if (fullvis) {
        const float bias = rowok ? 0.f : NEG_INF;
#pragma unroll
        for (int kt = 0; kt < 2; ++kt)
#pragma unroll
          for (int i = 0; i < 16; ++i) { const float v = s[kt][i] + bias; s[kt][i] = v; mx = fmaxf(mx, v); }
      } else {
#pragma unroll
        for (int kt = 0; kt < 2; ++kt)
#pragma unroll
          for (int i = 0; i < 16; ++i) {
            const int key = j * 64 + kt * 32 + crow(i, hh);
            const bool ok = rowok && key <= tq && key > klo;
            const float v = ok ? s[kt][i] : NEG_INF;
            s[kt][i] = v; mx = fmaxf(mx, v);
          }
      }
      mx = fmaxf(mx, swap32(mx, lane)) * SM_C;
      const float mnew = fmaxf(mrun, mx);
      const float msafe = (mnew == NEG_INF) ? 0.f : mnew;
      const float alpha = __builtin_amdgcn_exp2f(mrun - msafe);
      float psum = 0.f;
#pragma unroll
      for (int kt = 0; kt < 2; ++kt)
#pragma unroll
        for (int i = 0; i < 16; ++i) { const float e = __builtin_amdgcn_exp2f(__builtin_fmaf(s[kt][i], SM_C, -msafe)); s[kt][i] = e; psum += e; }
      psum += swap32(psum, lane);
      lrun = lrun * alpha + psum;
      mrun = mnew;
#pragma unroll
      for (int dt = 0; dt < 2; ++dt)
#pragma unroll
        for (int i = 0; i < 16; ++i) oa[dt][i] *= alpha;
#pragma unroll
      for (int kt = 0; kt < 2; ++kt)
#pragma unroll
        for (int s2 = 0; s2 < 2; ++s2) {
          const bf16x8 pf = pack8(s[kt], s2);
#pragma unroll
          for (int dt = 0; dt < 2; ++dt) {
            const u16* vp = sVt + (dt * 32 + l31) * 136 + kt * 32 + 16 * s2 + 4 * hh;
            s16x4 lo = *(const s16x4*)vp, hi = *(const s16x4*)(vp + 8);
            bf16x8 vf = __builtin_shufflevector(lo, hi, 0, 1, 2, 3, 4, 5, 6, 7);
            oa[dt] = MFMA32(vf, pf, oa[dt]);
          }
        }
    }
    {
      const float gate = GATES[tokq * 48 + head * 3 + 2];
      const float sc = gate / fmaxf(lrun, 1e-30f);
#pragma unroll
      for (int dt = 0; dt < 2; ++dt)
#pragma unroll
        for (int i = 0; i < 16; ++i) otot[dt][i] += sc * oa[dt][i];
    }
  }
#pragma unroll
  for (int dt = 0; dt < 2; ++dt)
#pragma unroll
    for (int i = 0; i < 16; ++i) NO[tokq * 1024 + head * 64 + dt * 32 + crow(i, hh)] = f2bf(otot[dt][i]);
}

__constant__ unsigned char PROG[48] = {
  0x01,0x02,0x03,0x04,0x05,0x06,0x07,0x09,0x0a,0x0b,0x0c,0x0d,
  0x11,0x12,0x13,0x14,0x15,0x16,0x18,0x19,0x1a,0x1b,0x1c,0x1d,
  0x21,0x22,0x23,0x24,0x25,0x26,0x27,0x29,0x2a,0x2b,0x2c,0x2d,
  0x31,0x32,0x33,0x34,0x35,0x36,0x38,0x39,0x3a,0x3b,0x3c,0x3d};
constexpr int N_PHASES = 49;

DI void run_phase(const Params p, int ph, char* smem) {
  const int wv_ = p.wave;
  float* H = (float*)(p.ws + OFF_H);
  u16* HB = (u16*)(p.ws + OFF_HB);
  const int pcode = (ph == 0) ? 0 : (int)PROG[ph - 1];
  const int layer = pcode >> 4, step = pcode & 15;
  const int li = layer >> 1;
  const bool hyb = (layer & 1) == 0;
  u16* W_MIN = (u16*)(p.ws + OFF_W_MIN);
  u16* W_MOUT = (u16*)(p.ws + OFF_W_MOUT);
  u16* ACT = (u16*)(p.ws + OFF_ACT);
  if (ph == 0) init_phase(p.x, H, HB, wv_);
  else if (step == 3 || step == 10 || step == 13) {
    const int k = step == 3 ? 0 : (step == 10 ? 1 : 2);
    const bool last = (layer == 3 && step == 13);
    ln_phase(H, HB, p.ln_g + (size_t)(layer * 3 + k) * DM, p.ln_b + (size_t)(layer * 3 + k) * DM, last ? p.out : nullptr, (float*)(p.ws + OFF_STATS), wv_);
  }
  {
    int cset = -1, cl = layer;
    if (ph == 0) cset = 0;
    else if (step == 3) cset = 1;
    else if (step == 10) cset = 2;
    else if (step == 13 && layer < 3) { cset = 0; cl = layer + 1; }
    if (cset >= 0) {
      const bool chyb = (cl & 1) == 0; const int cli = cl >> 1;
      const int c0 = (cset == 1) ? 4 : 0, c1 = (cset == 1) ? (chyb ? 6 : 10) : 2;
#pragma unroll 1
      for (int cc = c0; cc < c1; ++cc) {
        const int sblk = (cset == 2) ? 1 : 0;
        const float* src; u16* dst; int K, N, Np, mode = 0;
        if (cset != 1 && cc == 0) { src = p.ffn_w_in + (size_t)(cl * 2 + sblk) * 1024 * 5632; dst = (u16*)(p.ws + OFF_W_FIN0 + sblk * SZ_W_FIN); K = 1024; N = 5632; Np = 5632; mode = 1; }
        else if (cset != 1) { src = p.ffn_w_out + (size_t)(cl * 2 + sblk) * 2816 * 1024; dst = (u16*)(p.ws + OFF_W_FOUT0 + sblk * SZ_W_FOUT); K = 2816; N = 1024; Np = 1024; }
        else if (cc == 4) { src = chyb ? p.hyb_w_in + (size_t)cli * 1024 * HYB_IN_N : p.nsa_w_in + (size_t)cli * 1024 * NSA_IN_N; dst = W_MIN; K = 1024; N = chyb ? HYB_IN_N : NSA_IN_N; Np = chyb ? HYB_IN_NP : NSA_IN_NP; }
        else if (cc == 5) { src = chyb ? p.hyb_w_out + (size_t)cli * 2048 * 1024 : p.nsa_w_out + (size_t)cli * 1024 * 1024; dst = W_MOUT; K = chyb ? 2048 : 1024; N = 1024; Np = 1024; }
        else if (cc < 8) { src = p.nsa_cmp_w1 + (size_t)(cli * 2 + cc - 6) * 2048 * 256; dst = (u16*)(p.ws + OFF_W_C1 + (cc - 6) * SZ_W_C1); K = 2048; N = 256; Np = 256; }
        else { src = p.nsa_cmp_w2 + (size_t)(cli * 2 + cc - 8) * 256 * 64; dst = (u16*)(p.ws + OFF_W_C2 + (cc - 8) * SZ_W_C2); K = 256; N = 64; Np = 256; }
        convT(src, dst, K, N, Np, mode, smem, wv_);
      }
    }
  }
  if (ph == 0) return;
  switch (step) {
    case 1: case 11: {
      EpiArgs ea{}; ea.cb = ACT;
      gemm_phase<EPI_FFN1>(HB, DM, (const u16*)(p.ws + OFF_W_FIN0 + (step == 1 ? 0 : 1) * SZ_W_FIN), M_TOK, 5632, 1024, ea, smem, wv_);
    } break;
    case 2: case 12: case 9: {
      EpiArgs ea{}; ea.f0 = H;
      {
        const int lnidx = (step == 2) ? (layer * 3 - 1) : (step == 9 ? layer * 3 : layer * 3 + 1);
        if (lnidx >= 0) { ea.lng = p.ln_g + (size_t)lnidx * DM; ea.lnb = p.ln_b + (size_t)lnidx * DM; ea.stats = (const float*)(p.ws + OFF_STATS); }
      }
      const u16* Ap; const u16* Wp; int lda, K;
      if (step == 9) {
        ea.scale = 1.0f; Wp = W_MOUT;
        if (hyb) { Ap = (const u16*)(p.ws + OFF_O); lda = 2048; K = 2048; } else { Ap = (const u16*)(p.ws + OFF_NO); lda = 1024; K = 1024; }
      } else {
        ea.scale = 0.5f; Ap = ACT; lda = DFF; K = DFF; Wp = (const u16*)(p.ws + OFF_W_FOUT0 + (step == 2 ? 0 : 1) * SZ_W_FOUT);
      }
#if SKIP_MIX
      if (step == 9) {
        const size_t n = (size_t)M_TOK * DM;
        for (size_t i = (size_t)lbid() * NTHREADS + ltid(); i < n; i += (size_t)gridDim.x * NTHREADS) H[i] *= ALPHA;
        break;
      }
#endif
      gemm_phase<EPI_RES>(Ap, lda, Wp, M_TOK, 1024, K, ea, smem, wv_);
    } break;
    case 3: case 10: case 13: break;
    case 4: {
#if !SKIP_MIX
      if (hyb) {
        EpiArgs ea{}; ea.cb = (u16*)(p.ws + OFF_PROJ); ea.f0 = (float*)(p.ws + OFF_GLOG); ea.f1 = (float*)(p.ws + OFF_SDTL);
        gemm_phase<EPI_HYBIN>(HB, DM, W_MIN, M_TOK, HYB_IN_NP, 1024, ea, smem, wv_);
      } else {
        EpiArgs ea{}; ea.cb = (u16*)(p.ws + OFF_PROJ); ea.f0 = (float*)(p.ws + OFF_NGATE);
        gemm_phase<EPI_NSAIN>(HB, DM, W_MIN, M_TOK, NSA_IN_NP, 1024, ea, smem, wv_);
      }
#endif
    } break;
    case 5: {
#if !SKIP_MIX
#ifndef NO_HPREP
      if (hyb) hyb_prep(p, li);
#endif
#ifndef NO_NPREP
      if (!hyb) nsa_prep(p, li);
#endif
#endif
    } break;
    case 6: {
#if !SKIP_MIX
      if (hyb) {
        for (int it0 = lbid(); it0 < 256; it0 += gridDim.x) {
          const int item = (gridDim.x == 256) ? ((it0 & 7) * 32 + (it0 >> 3)) : it0;
          scan_item(p, li, item, smem);
        }
      } else {
#pragma unroll 1
        for (int s = 0; s < 2; ++s) {
          EpiArgs ea{}; ea.cb = (u16*)(p.ws + (s == 0 ? OFF_HIDK : OFF_HIDV)); ea.ldc = 256;
          gemm_phase<EPI_SILU>((const u16*)(p.ws + (s == 0 ? OFF_FLATK : OFF_FLATV)), 2048, (const u16*)(p.ws + OFF_W_C1 + s * SZ_W_C1), 2048, 256, 2048, ea, smem, wv_, s * 8);
        }
#pragma unroll 1
        for (int s = 0; s < 2; ++s) {
          EpiArgs ea{}; ea.cb = (u16*)(p.ws + (s == 0 ? OFF_KCMP : OFF_VCMP)); ea.ldc = 64; ea.nvalid = 64;
          gemm_phase<EPI_PLAIN>((const u16*)(p.ws + (s == 0 ? OFF_HIDK : OFF_HIDV)), 256, (const u16*)(p.ws + OFF_W_C2 + s * SZ_W_C2), 2048, 256, 256, ea, smem, wv_, s * 8);
        }
      }
#endif
    } break;
    case 7: {
#if !SKIP_MIX
#ifndef NO_HPOST
      if (hyb) hyb_post(p, li);
#endif
#endif
    } break;
    case 8: {
#if !SKIP_MIX
      #ifndef NO_ATTN
      if (!hyb) {
        for (int it0 = lbid(); it0 < 1024; it0 += gridDim.x) {
          int item = it0, flip = (it0 >> 8) & 1;
          if (gridDim.x == 256) {
            const int r = it0 >> 8, lix = (lbid() >> 3) + 32 * r;
            item = ((lbid() & 7) << 7) | lix; flip = lix >> 6;
          }
          nsa_attn_item(p, item, flip, smem);
        }
      }
#endif
#endif
    } break;
  }
}


#define XB_TMO      128
#define XB_XCNT(j)  (256  + 64 * (j))
#define XB_XSUB(j)  (1280 + 64 * (j))
#define XB_XGEN(j)  (2304 + 64 * (j))
#define XB_TOP      3328
#define XB_TOPGEN   3392
#define XCD_BAR_WORDS 3456
#define XL_SUB(j) (3456 + 64 * (j))
#define XL_GEN(j) (4480 + 64 * (j))
#define XL_MAP(g) (5504 + (g))
#define XL_BAD    5568
#define ALL_BAR_WORDS 5632
#define XB_SPIN_CAP (1u << 18)
#define LAS __attribute__((address_space(3)))
DI unsigned xb_ld(unsigned* p)              { return __hip_atomic_load(p, __ATOMIC_RELAXED, __HIP_MEMORY_SCOPE_AGENT); }
DI unsigned xb_add(unsigned* p, unsigned v) { return __hip_atomic_fetch_add(p, v, __ATOMIC_RELAXED, __HIP_MEMORY_SCOPE_AGENT); }
DI unsigned xb_xcc_id() { return (unsigned)__builtin_amdgcn_s_getreg((3 << 11) | 20) & 0xFu; }
#define XB_SPIN(cond, bar) do { unsigned _sp = 0; while (cond) { __builtin_amdgcn_s_sleep(1); \
    if ((++_sp & 255u) == 0u) { if (xb_ld(&(bar)[XB_TMO])) break; if (_sp > XB_SPIN_CAP) { atomicAdd(&(bar)[XB_TMO], 1u); break; } } } } while (0)
struct XcdBarrier { unsigned* bar; unsigned x; volatile LAS unsigned* st; };
DI XcdBarrier xcd_barrier_post(unsigned* bar, volatile LAS unsigned* st, int tid) {
  XcdBarrier b; b.bar = bar; b.x = xb_xcc_id(); b.st = st;
  if (tid == 0) (void)xb_add(&bar[XB_XCNT(b.x)], 1u);
  return b;
}
DI void xcd_barrier_complete(unsigned* bar, unsigned x, unsigned& nloc, unsigned& nx) {
  const unsigned G = gridDim.x * gridDim.y * gridDim.z;
  unsigned sum, cnt, mine, sp = 0u;
  for (;;) {
    sum = 0u; cnt = 0u; mine = 0u;
#pragma unroll
    for (unsigned j = 0; j < 16; ++j) { const unsigned c = xb_ld(&bar[XB_XCNT(j)]); sum += c; cnt += (c > 0u) ? 1u : 0u; mine = (j == x) ? c : mine; }
    if (sum == G) break;
    __builtin_amdgcn_s_sleep(1);
    if ((++sp & 255u) == 0u) { if (xb_ld(&bar[XB_TMO])) break; if (sp > XB_SPIN_CAP) { atomicAdd(&bar[XB_TMO], 1u); break; } }
  }
  nloc = mine > 0u ? mine : 1u; nx = cnt > 0u ? cnt : 1u;
}
DI void xcd_barrier(const XcdBarrier& b, int tid) {
  asm volatile("s_waitcnt vmcnt(0)" ::: "memory");
  __syncthreads();
  if (tid == 0) {
    unsigned* bar = b.bar;
    __builtin_amdgcn_s_waitcnt(0);
    unsigned nloc = b.st[0], nx = b.st[1];
    if (nloc == 0u) { xcd_barrier_complete(bar, b.x, nloc, nx); b.st[0] = nloc; b.st[1] = nx; }
    const unsigned old = xb_add(&bar[XB_XSUB(b.x)], 1u);
    const unsigned gen = old / nloc;
    if (old + 1u == (gen + 1u) * nloc) {
      __builtin_amdgcn_fence(__ATOMIC_RELEASE, "agent");
      asm volatile("s_waitcnt vmcnt(0)" ::: "memory");
      const unsigned og = xb_add(&bar[XB_TOP], 1u);
      const unsigned tg = og / nx;
      if (og + 1u == (tg + 1u) * nx) xb_add(&bar[XB_TOPGEN], 1u);
      else XB_SPIN(xb_ld(&bar[XB_TOPGEN]) == tg, bar);
      __builtin_amdgcn_fence(__ATOMIC_ACQUIRE, "agent");
      xb_add(&bar[XB_XGEN(b.x)], 1u);
      asm volatile("s_waitcnt vmcnt(0)" ::: "memory");
    } else {
      XB_SPIN(xb_ld(&bar[XB_XGEN(b.x)]) == gen, bar);
      __builtin_amdgcn_fence(__ATOMIC_ACQUIRE, "agent");
      asm volatile("s_waitcnt vmcnt(0)" ::: "memory");
    }
  }
  __syncthreads();
}

DI void xcc_local_barrier(const XcdBarrier& b, int tid) {
  asm volatile("s_waitcnt vmcnt(0)" ::: "memory");
  __syncthreads();
  if (tid == 0) {
    unsigned* bar = b.bar;
    __builtin_amdgcn_s_waitcnt(0);
    const unsigned old = xb_add(&bar[XL_SUB(b.x)], 1u);
    const unsigned gen = old / 32u;
    if (old + 1u == (gen + 1u) * 32u) {
      __builtin_amdgcn_fence(__ATOMIC_RELEASE, "agent");
      asm volatile("s_waitcnt vmcnt(0)" ::: "memory");
      __builtin_amdgcn_fence(__ATOMIC_ACQUIRE, "agent");
      xb_add(&bar[XL_GEN(b.x)], 1u);
      asm volatile("s_waitcnt vmcnt(0)" ::: "memory");
    } else {
      XB_SPIN(xb_ld(&bar[XL_GEN(b.x)]) == gen, bar);
      __builtin_amdgcn_fence(__ATOMIC_ACQUIRE, "agent");
      asm volatile("s_waitcnt vmcnt(0)" ::: "memory");
    }
  }
  __syncthreads();
}

__global__ void __launch_bounds__(NTHREADS, 2) mega_kernel(Params p, int ph_begin, int ph_end) {
  __shared__ __attribute__((aligned(16))) char smem[131072];
  cg::grid_group grid = cg::this_grid();
  const int wave_id = __builtin_amdgcn_readfirstlane(threadIdx.x >> 6);
  __shared__ uint4 xb_words;
  if (threadIdx.x == 0) xb_words = make_uint4(0u, 0u, 0u, 0u);
  __syncthreads();
  const XcdBarrier xb = xcd_barrier_post((unsigned*)(p.ws + OFF_BAR), (volatile LAS unsigned*)&xb_words, (int)threadIdx.x);
  if (threadIdx.x == 0) {
    unsigned* bar = (unsigned*)(p.ws + OFF_BAR);
    const unsigned v = xb.x + 1u;
    const unsigned old = atomicCAS(&bar[XL_MAP(blockIdx.x & 7)], 0u, v);
    if (old != 0u && old != v) atomicOr(&bar[XL_BAD], 1u);
  }
  bool affine_ok = false;
  for (int ph = ph_begin; ph < ph_end; ++ph) {
    Params q = p;
    { size_t zoff = 0; asm volatile("" : "+s"(zoff)); q.ws = p.ws + zoff; }
    q.wave = wave_id;
    run_phase(q, ph, smem);
#ifdef PROBE_DOUBLE
    if (ph > 0) {
      const int step = (ph - 1) % PH_PER_LAYER;
      if ((PROBE_DOUBLE == 1 && (step == 1 || step == 11 || step == 4)) ||
          (PROBE_DOUBLE == 2 && (step == 0 || step == 5 || step == 7 || step == 8)) ) {
        grid.sync();
        run_phase(q, ph, smem);
      }
    }
#endif
    if (ph + 1 < ph_end) {
      if (ph_end < 0) grid.sync();
      {
        const int wv_ = wave_id;
        bool local_ok = false;
        if (affine_ok && ph >= 2) {
          const int pc = (int)PROG[ph - 1], bstep = pc & 15, bnsa = (pc >> 4) & 1;
          local_ok = !(bstep == 3 || bstep == 10 || bstep == 13 || (bnsa && bstep >= 5 && bstep <= 7));
        }
        if (local_ok) xcc_local_barrier(xb, ltid());
        else xcd_barrier(xb, ltid());
        if (ph == 0) {
          if (threadIdx.x == 0 && xb_words.x != 32u) atomicOr(&xb.bar[XL_BAD], 1u);
        } else if (ph == 1) {
          if (threadIdx.x == 0) xb_words.z = (xb_ld(&xb.bar[XL_BAD]) == 0u && gridDim.x == 256) ? 1u : 0u;
          __syncthreads();
          affine_ok = xb_words.z != 0u;
        }
      }
    }
  }
}

extern "C" void kernel_launch(void* const* d_in, const int* in_sizes, int n_in, void* d_out, int out_size, void* d_ws, size_t ws_size,
                              hipStream_t stream) {
  static int grid_blocks = 0;
  if (!grid_blocks) {
    int dev = 0, cus = 0, per_cu = 0;
    hipGetDevice(&dev);
    hipDeviceGetAttribute(&cus, hipDeviceAttributeMultiprocessorCount, dev);
    hipOccupancyMaxActiveBlocksPerMultiprocessor(&per_cu, mega_kernel, NTHREADS, 0);
    if (per_cu > 1) per_cu = 1;
    if (per_cu < 1) per_cu = 1;
    grid_blocks = cus * per_cu;
  }
  Params p{};
  p.x = (const float*)d_in[0]; p.pos = (const int*)d_in[1];
  p.ln_g = (const float*)d_in[2]; p.ln_b = (const float*)d_in[3];
  p.ffn_w_in = (const float*)d_in[4]; p.ffn_w_out = (const float*)d_in[5];
  p.hyb_w_in = (const float*)d_in[6]; p.gdn_conv_w = (const float*)d_in[7]; p.gdn_a_log = (const float*)d_in[8];
  p.gdn_dt_bias = (const float*)d_in[9]; p.gdn_norm_w = (const float*)d_in[10];
  p.ssd_conv_w = (const float*)d_in[11]; p.ssd_conv_b = (const float*)d_in[12]; p.ssd_a_log = (const float*)d_in[13];
  p.ssd_dt_bias = (const float*)d_in[14]; p.ssd_d = (const float*)d_in[15]; p.ssd_norm_w = (const float*)d_in[16];
  p.hyb_w_out = (const float*)d_in[17];
  p.nsa_w_in = (const float*)d_in[18]; p.nsa_cmp_pos = (const float*)d_in[19]; p.nsa_cmp_w1 = (const float*)d_in[20];
  p.nsa_cmp_w2 = (const float*)d_in[21]; p.nsa_w_out = (const float*)d_in[22];
  p.out = (float*)d_out;
  p.ws = (char*)d_ws;
  hipMemsetAsync((char*)d_ws + OFF_BAR, 0, ALL_BAR_WORDS * 4, stream);
#if USE_COOP
  int b0 = 0, b1 = N_PHASES;
  void* args[] = {&p, &b0, &b1};
  hipError_t e = hipLaunchCooperativeKernel((void*)mega_kernel, dim3(grid_blocks), dim3(NTHREADS), args, 0, stream);
  if (e != hipSuccess) fprintf(stderr, "cooperative launch failed: %s (grid %d)\n", hipGetErrorString(e), grid_blocks);
#else
  for (int ph = 0; ph < N_PHASES; ++ph) mega_kernel<<<dim3(grid_blocks), dim3(NTHREADS), 0, stream>>>(p, ph, ph + 1);
#endif
}
```

```cpp
#include <hip/hip_runtime.h>
#include <hip/hip_bf16.h>
#include <hip/hip_cooperative_groups.h>
#include <cstdio>
#include <cstdint>
namespace cg = cooperative_groups;

typedef unsigned short u16;
using bf16x8 = __attribute__((ext_vector_type(8))) short;
using s16x4  = __attribute__((ext_vector_type(4))) short;
using f32x16 = __attribute__((ext_vector_type(16))) float;
using v2f = __attribute__((ext_vector_type(2))) float;

#ifndef USE_COOP
#define USE_COOP 1
#endif
#ifndef SKIP_MIX
#define SKIP_MIX 0
#endif

#define DI __device__ __forceinline__

constexpr int M_TOK = 16384;
constexpr int T_SEQ = 2048;
constexpr int DM = 1024;
constexpr int DFF = 2816;
constexpr int HYB_IN_N = 5664, HYB_IN_NP = 5888;
constexpr int NSA_IN_N = 1840, NSA_IN_NP = 2048;
constexpr float ALPHA = 1.681792830507429f;
constexpr int NTHREADS = 512;

constexpr size_t al(size_t x) { return (x + 255) & ~size_t(255); }
constexpr size_t OFF_W_FIN0 = 0;
constexpr size_t SZ_W_FIN = (size_t)5632 * 1024 * 2;
constexpr size_t OFF_W_FIN1 = OFF_W_FIN0 + SZ_W_FIN;
constexpr size_t OFF_W_FOUT0 = OFF_W_FIN1 + SZ_W_FIN;
constexpr size_t SZ_W_FOUT = (size_t)1024 * 2816 * 2;
constexpr size_t OFF_W_FOUT1 = OFF_W_FOUT0 + SZ_W_FOUT;
constexpr size_t OFF_W_MIN = OFF_W_FOUT1 + SZ_W_FOUT;
constexpr size_t SZ_W_MIN = (size_t)HYB_IN_NP * 1024 * 2;
constexpr size_t OFF_W_MOUT = OFF_W_MIN + SZ_W_MIN;
constexpr size_t SZ_W_MOUT = (size_t)1024 * 2048 * 2;
constexpr size_t OFF_W_C1 = OFF_W_MOUT + SZ_W_MOUT;
constexpr size_t SZ_W_C1 = (size_t)256 * 2048 * 2;
constexpr size_t OFF_W_C2 = OFF_W_C1 + 2 * SZ_W_C1;
constexpr size_t SZ_W_C2 = (size_t)256 * 256 * 2;
constexpr size_t OFF_STATS = al(OFF_W_C2 + 2 * SZ_W_C2);
constexpr size_t OFF_BAR = al(OFF_STATS + (size_t)M_TOK * 8);
constexpr size_t OFF_H = al(OFF_BAR + 5632 * 4);
constexpr size_t OFF_HB = OFF_H + (size_t)M_TOK * DM * 4;
constexpr size_t OFF_R = OFF_HB + (size_t)M_TOK * DM * 2;
constexpr size_t OFF_ACT = OFF_R;
constexpr size_t OFF_PROJ = OFF_R;
constexpr size_t OFF_GLOG = OFF_PROJ + (size_t)M_TOK * HYB_IN_N * 2;
constexpr size_t OFF_SDTL = OFF_GLOG + (size_t)M_TOK * 16 * 4;
constexpr size_t OFF_GQ = OFF_SDTL + (size_t)M_TOK * 16 * 4;
constexpr size_t OFF_GK = OFF_GQ + (size_t)M_TOK * 512 * 4;
constexpr size_t OFF_GV = OFF_GK + (size_t)M_TOK * 512 * 4;
constexpr size_t OFF_GA = OFF_GV + (size_t)M_TOK * 1024 * 4;
constexpr size_t OFF_GB = OFF_GA + (size_t)M_TOK * 8 * 4;
constexpr size_t OFF_SX = OFF_GB + (size_t)M_TOK * 8 * 4;
constexpr size_t OFF_SB = OFF_SX + (size_t)M_TOK * 1024 * 4;
constexpr size_t OFF_SC = OFF_SB + (size_t)M_TOK * 256 * 4;
constexpr size_t OFF_SDT = OFF_SC + (size_t)M_TOK * 256 * 4;
constexpr size_t OFF_SDA = OFF_SDT + (size_t)M_TOK * 16 * 4;
constexpr size_t OFF_O = OFF_SDA + (size_t)M_TOK * 16 * 4;
constexpr size_t OFF_END_HYB = OFF_O + (size_t)M_TOK * 2048 * 2;
constexpr size_t OFF_NGATE = OFF_PROJ + (size_t)M_TOK * HYB_IN_N * 2;
constexpr size_t OFF_QROT = OFF_NGATE + (size_t)M_TOK * 48 * 4;
constexpr size_t OFF_KSR = OFF_QROT + (size_t)M_TOK * 256 * 2;
constexpr size_t OFF_KWR = OFF_KSR + (size_t)M_TOK * 128 * 2;
constexpr size_t OFF_FLATK = OFF_KWR + (size_t)M_TOK * 128 * 2;
constexpr size_t OFF_FLATV = OFF_FLATK + (size_t)2048 * 2048 * 2;
constexpr size_t OFF_HIDK = OFF_FLATV + (size_t)2048 * 2048 * 2;
constexpr size_t OFF_HIDV = OFF_HIDK + (size_t)2048 * 256 * 2;
constexpr size_t OFF_KCMP = OFF_HIDV + (size_t)2048 * 256 * 2;
constexpr size_t OFF_VCMP = OFF_KCMP + (size_t)2048 * 64 * 2;
constexpr size_t OFF_NO = OFF_VCMP + (size_t)2048 * 64 * 2;

struct Params {
  const float* x; const int* pos;
  const float *ln_g, *ln_b, *ffn_w_in, *ffn_w_out, *hyb_w_in, *gdn_conv_w, *gdn_a_log, *gdn_dt_bias, *gdn_norm_w;
  const float *ssd_conv_w, *ssd_conv_b, *ssd_a_log, *ssd_dt_bias, *ssd_d, *ssd_norm_w, *hyb_w_out;
  const float *nsa_w_in, *nsa_cmp_pos, *nsa_cmp_w1, *nsa_cmp_w2, *nsa_w_out;
  float* out;
  char* ws;
  int wave; int pad_;
};

DI int ltid_(int wv) { int t = (wv << 6) | (int)__builtin_amdgcn_mbcnt_hi(~0u, __builtin_amdgcn_mbcnt_lo(~0u, 0u)); asm volatile("" : "+v"(t)); return t; }
#define ltid() ltid_(wv_)
DI int lbid() { int t = blockIdx.x; asm volatile("" : "+s"(t)); return t; }
typedef __bf16 bf16v2 __attribute__((ext_vector_type(2)));
DI u16 f2bf(float x) { return __builtin_bit_cast(u16, (__bf16)x); }
DI float bf2f(u16 v) { return __uint_as_float(((unsigned)v) << 16); }
DI unsigned pack2(float a, float b) { v2f v = {a, b}; return __builtin_bit_cast(unsigned, __builtin_convertvector(v, bf16v2)); }
DI float4 ld4bf(const u16* p) { const uint2 u = *(const uint2*)p; return make_float4(__uint_as_float(u.x << 16), __uint_as_float(u.x & 0xffff0000u), __uint_as_float(u.y << 16), __uint_as_float(u.y & 0xffff0000u)); }
DI void st4bf(u16* p, float4 v) { uint2 u; u.x = pack2(v.x, v.y); u.y = pack2(v.z, v.w); *(uint2*)p = u; }
DI float silu_f(float x) { return x * __builtin_amdgcn_rcpf(1.f + __expf(-x)); }
DI float sigmoid_acc(float x) { return 1.f / (1.f + expf(-x)); }
DI float softplus_acc(float x) { return fmaxf(x, 0.f) + log1pf(expf(-fabsf(x))); }
#define DPP_ADD(v, ctrl) (v) += __int_as_float(__builtin_amdgcn_update_dpp(0, __float_as_int(v), (ctrl), 0xF, 0xF, false))
DI float red16(float v) {
  DPP_ADD(v, 0xB1); DPP_ADD(v, 0x4E); DPP_ADD(v, 0x141); DPP_ADD(v, 0x140);
  return v;
}
DI float wave_sum(float v) {
  v = red16(v);
  const int iv = __float_as_int(v);
  return __int_as_float(__builtin_amdgcn_readlane(iv, 0)) + __int_as_float(__builtin_amdgcn_readlane(iv, 16)) +
         __int_as_float(__builtin_amdgcn_readlane(iv, 32)) + __int_as_float(__builtin_amdgcn_readlane(iv, 48));
}
DI float swap32(float v, int lane) {
  return __int_as_float(__builtin_amdgcn_ds_bpermute((lane ^ 32) << 2, __float_as_int(v)));
}
DI int crow(int i, int h) { return (i & 3) + 8 * (i >> 2) + 4 * h; }
#define MFMA32(a, b, c) __builtin_amdgcn_mfma_f32_32x32x16_bf16((a), (b), (c), 0, 0, 0)

DI void convT(const float* __restrict__ src, u16* __restrict__ dst, int K, int N, int Npad, int mode, char* smem, int wv_) {
  float* tl = (float*)smem;
  const int tid = ltid();
  const int tk = K / 64, tn = Npad / 128;
  const int ntile = tk * tn;
  const int lk = tid >> 7, ln = tid & 127;
  float rv[16];
  int tile = lbid();
  if (tile < ntile) {
    const int k0 = (tile % tk) * 64, n0 = (tile / tk) * 128;
#pragma unroll
    for (int r = 0; r < 16; ++r) rv[r] = (n0 + ln < N) ? src[(size_t)(k0 + r * 4 + lk) * N + n0 + ln] : 0.f;
  }
  for (; tile < ntile; tile += gridDim.x) {
    const int k0 = (tile % tk) * 64, n0 = (tile / tk) * 128;
    __syncthreads();
#pragma unroll
    for (int r = 0; r < 16; ++r) tl[(r * 4 + lk) * 129 + ln] = rv[r];
    __syncthreads();
    const int nxt = tile + gridDim.x;
    if (nxt < ntile) {
      const int k1 = (nxt % tk) * 64, n1 = (nxt / tk) * 128;
#pragma unroll
      for (int r = 0; r < 16; ++r) rv[r] = (n1 + ln < N) ? src[(size_t)(k1 + r * 4 + lk) * N + n1 + ln] : 0.f;
    }
#pragma unroll
    for (int r = 0; r < 8; ++r) {
      const int n = r * 16 + (tid >> 5), kk = (tid & 31) * 2;
      const int ng = n0 + n;
      int row = ng;
      if (mode == 1) { int up = ng >= DFF; int j = ng - up * DFF; row = (j >> 4) * 32 + up * 16 + (j & 15); }
      *(unsigned*)(dst + (size_t)row * K + k0 + kk) = pack2(tl[kk * 129 + n], tl[(kk + 1) * 129 + n]);
    }
  }
}

#define XCD_AFF_DECL const int xa_x = lbid() & 7, xa_slot = (lbid() >> 3) * (NTHREADS / 64) + (ltid() >> 6), xa_wpx = (int)(gridDim.x >> 3) * (NTHREADS / 64); \
  const bool xa_on = ((int)(gridDim.x >> 3) << 3) == (int)gridDim.x
DI void ln_phase(float* __restrict__ h, u16* __restrict__ hb, const float* __restrict__ g, const float* __restrict__ b, float* __restrict__ outp, float* __restrict__ stats, int wv_) {
  const int lane = ltid() & 63;
  XCD_AFF_DECL;
  const int wave = xa_on ? xa_slot : ((lbid() * NTHREADS + ltid()) >> 6), nw = xa_on ? xa_wpx : (int)gridDim.x * (NTHREADS / 64);
  const int rbase = xa_on ? xa_x * (M_TOK / 8) : 0, rcnt = xa_on ? M_TOK / 8 : M_TOK;
  for (int rr = wave; rr < rcnt; rr += nw) {
    const int row = rbase + rr;
    float4 v[4];
    float s = 0.f;
#pragma unroll
    for (int i = 0; i < 4; ++i) { v[i] = *(const float4*)(h + (size_t)row * DM + i * 256 + lane * 4); s += v[i].x + v[i].y + v[i].z + v[i].w; }
    s = wave_sum(s);
    const float mu = s * (1.f / DM);
    float q = 0.f;
#pragma unroll
    for (int i = 0; i < 4; ++i) { float a = v[i].x - mu, bb = v[i].y - mu, c = v[i].z - mu, d = v[i].w - mu; q += a * a + bb * bb + c * c + d * d; }
    q = wave_sum(q);
    const float rstd = rsqrtf(q * (1.f / DM) + 1e-5f);
    if (lane == 0) *(float2*)(stats + (size_t)row * 2) = make_float2(mu, rstd);
#pragma unroll
    for (int i = 0; i < 4; ++i) {
      const int col = i * 256 + lane * 4;
      float4 gg = *(const float4*)(g + col), bb = *(const float4*)(b + col);
      float4 y;
      y.x = (v[i].x - mu) * rstd * gg.x + bb.x; y.y = (v[i].y - mu) * rstd * gg.y + bb.y;
      y.z = (v[i].z - mu) * rstd * gg.z + bb.z; y.w = (v[i].w - mu) * rstd * gg.w + bb.w;
      if (outp) { *(float4*)(outp + (size_t)row * DM + col) = y; }
      else {
        uint2 pk; pk.x = pack2(y.x, y.y); pk.y = pack2(y.z, y.w);
        *(uint2*)(hb + (size_t)row * DM + col) = pk;
      }
    }
  }
}

DI void init_phase(const float* __restrict__ x, float* __restrict__ h, u16* __restrict__ hb, int wv_) {
  const size_t n4 = (size_t)M_TOK * DM / 4;
  for (size_t i = (size_t)lbid() * NTHREADS + ltid(); i < n4; i += (size_t)gridDim.x * NTHREADS) {
    float4 v = ((const float4*)x)[i];
    uint2 pk; pk.x = pack2(v.x, v.y); pk.y = pack2(v.z, v.w);
    ((uint2*)hb)[i] = pk;
  }
}

enum { EPI_FFN1 = 0, EPI_RES = 1, EPI_HYBIN = 2, EPI_NSAIN = 3, EPI_SILU = 4, EPI_PLAIN = 5 };
struct EpiArgs {
  u16* cb;
  int ldc;
  int nvalid;
  int mvalid;
  float* f0;
  float* f1;
  float scale;
  const float* lng;
  const float* lnb;
  const float* stats;
  const float* fin;
};
using f32x4 = __attribute__((ext_vector_type(4))) float;
constexpr int G_BM = 256, G_BK = 64, G_HALF = 128, G_HT = G_HALF * G_BK;
DI int lds_byte(int r, int c) {
  int st = (r >> 4) * 2 + (c >> 5), rr = r & 15, cc = c & 31, ob = rr * 64 + cc * 2;
  return st * 1024 + (ob ^ (((ob >> 9) & 1) << 5));
}
DI void stage_rc(int b, int& R, int& C) {
  int st = b / 1024, sb = b % 1024, swz = sb ^ (((sb >> 9) & 1) << 5);
  R = (st >> 1) * 16 + swz / 64; C = (st & 1) * 32 + (swz % 64) / 2;
}

template <int MODE>
DI void gemm_phase(const u16* __restrict__ A, int lda_unused, const u16* __restrict__ Bt, int Mrows, int Npad, int K, EpiArgs ea, char* smem, int wv_, int blk_off = 0) {
  u16* shm = (u16*)smem;
#define SA(b, h) (shm + ((b) * 2 + (h)) * G_HT)
#define SB(b, h) (shm + (4 + (b) * 2 + (h)) * G_HT)
#define STAGE(P, BASE, br, kt) do { const char* _g = ((br) == (BASE##row0)) ? c##BASE : c##BASE##h; const unsigned _ko = (unsigned)(kt) * (G_BK * 2u); \
    __builtin_amdgcn_global_load_lds((const unsigned*)(_g + (size_t)(so0 + _ko)), (unsigned*)((char*)(P) + sb0), 16, 0, 0); \
    __builtin_amdgcn_global_load_lds((const unsigned*)(_g + (size_t)(so1 + _ko)), (unsigned*)((char*)(P) + sb0 + 8192), 16, 0, 0); } while (0)
#define LDA(dst, b, h) _Pragma("unroll") for (int m = 0; m < 4; ++m) _Pragma("unroll") for (int k = 0; k < 2; ++k) \
    dst[m][k] = *reinterpret_cast<const bf16x8*>((char*)SA(b, h) + aoff + m * 2048 + k * 1024)
#define LDB(dst, b, h) _Pragma("unroll") for (int n = 0; n < 2; ++n) _Pragma("unroll") for (int k = 0; k < 2; ++k) \
    dst[n][k] = *reinterpret_cast<const bf16x8*>((char*)SB(b, h) + boff + n * 2048 + k * 1024)
#define MMA(ai, bj, At_, Bt_) do { __builtin_amdgcn_s_setprio(1); \
    _Pragma("unroll") for (int m = 0; m < 4; ++m) _Pragma("unroll") for (int n = 0; n < 2; ++n) _Pragma("unroll") for (int k = 0; k < 2; ++k) \
      acc[ai][bj][m][n] = __builtin_amdgcn_mfma_f32_16x16x32_bf16(Bt_[n][k], At_[m][k], acc[ai][bj][m][n], 0, 0, 0); \
    __builtin_amdgcn_s_setprio(0); } while (0)
#define WAIT_V(n) asm volatile("s_waitcnt vmcnt(" #n ")" ::: "memory")
#define WAIT_L(n) asm volatile("s_waitcnt lgkmcnt(" #n ")" ::: "memory")
#define BAR __builtin_amdgcn_s_barrier()
#define SCHED __builtin_amdgcn_sched_barrier(0)
  const int tid = ltid();
  const int wid = tid >> 6, lane = tid & 63, wr = wid >> 2, wc = wid & 3, fr = lane & 15, fq = lane >> 4;
  const int nM = Mrows / G_BM, nN = Npad / G_BM, nwg = nM * nN;
  const int sb0 = tid * 16;
  const int nt = K / G_BK;
  const int aoff = lds_byte(wr * 64 + fr, fq * 8), boff = lds_byte(wc * 32 + fr, fq * 8);
  int tile_first = lbid() - blk_off;
  if (tile_first < 0) tile_first += gridDim.x;
  for (int tile = tile_first; tile < nwg; tile += gridDim.x) {
    int wgid = tile;
    { int q = nwg / 8, r = nwg % 8, xcd = wgid % 8, off = wgid / 8;
      wgid = (xcd < r ? xcd * (q + 1) : r * (q + 1) + (xcd - r) * q) + off; }
    const int nig = 4 * nN, gid = wgid / nig, fm = gid * 4, gsz = min(nM - fm, 4);
    const int pm = fm + ((wgid % nig) % gsz), pn = (wgid % nig) / gsz, brow = pm * G_BM, bcol = pn * G_BM;
    const int Arow0 = brow, Btrow0 = bcol;
    const size_t kb2 = (size_t)K * 2;
    const char* cA = (const char*)A + (size_t)brow * kb2;
    const char* cBt = (const char*)Bt + (size_t)bcol * kb2;
    unsigned so0, so1;
    { const int tb = ltid() * 16; int r_, c_; stage_rc(tb, r_, c_); so0 = (unsigned)(r_ * K + c_) * 2u; stage_rc(tb + 8192, r_, c_); so1 = (unsigned)(r_ * K + c_) * 2u; }
    const char* cAh = cA + (size_t)G_HALF * kb2;
    const char* cBth = cBt + (size_t)G_HALF * kb2;
    asm volatile("" : "+s"(cA), "+s"(cBt), "+s"(cAh), "+s"(cBth), "+v"(so0), "+v"(so1));
    f32x4 acc[2][2][4][2];
#pragma unroll
    for (int a = 0; a < 2; ++a)
#pragma unroll
      for (int b = 0; b < 2; ++b)
#pragma unroll
        for (int m = 0; m < 4; ++m)
#pragma unroll
          for (int n = 0; n < 2; ++n) acc[a][b][m][n] = f32x4{0.f, 0.f, 0.f, 0.f};
    bf16x8 At[4][2], B0[2][2], B1[2][2];
    STAGE(SB(0, 0), Bt, bcol, 0); STAGE(SA(0, 0), A, brow, 0);
    STAGE(SB(0, 1), Bt, bcol + G_HALF, 0); STAGE(SA(0, 1), A, brow + G_HALF, 0);
    if (wr == 1) BAR;
    WAIT_V(4); BAR;
    STAGE(SB(1, 0), Bt, bcol, 1); STAGE(SA(1, 0), A, brow, 1); STAGE(SB(1, 1), Bt, bcol + G_HALF, 1);
    WAIT_V(6); BAR;
    for (int t = 0; t < nt - 2; t += 2) {
      LDB(B0, 0, 0); SCHED; LDA(At, 0, 0); STAGE(SA(1, 1), A, brow + G_HALF, t + 1);
      WAIT_L(8); BAR; WAIT_L(0); MMA(0, 0, At, B0); BAR; SCHED;
      LDB(B1, 0, 1); STAGE(SB(0, 0), Bt, bcol, t + 2);
      BAR; WAIT_L(0); MMA(0, 1, At, B1); BAR;
      LDA(At, 0, 1); STAGE(SA(0, 0), A, brow, t + 2);
      BAR; WAIT_L(0); MMA(1, 0, At, B0); BAR; SCHED;
      STAGE(SB(0, 1), Bt, bcol + G_HALF, t + 2);
      WAIT_V(6); BAR; MMA(1, 1, At, B1); BAR;
      LDB(B0, 1, 0); SCHED; LDA(At, 1, 0); STAGE(SA(0, 1), A, brow + G_HALF, t + 2);
      WAIT_L(8); BAR; WAIT_L(0); MMA(0, 0, At, B0); BAR; SCHED;
      LDB(B1, 1, 1); STAGE(SB(1, 0), Bt, bcol, t + 3);
      BAR; WAIT_L(0); MMA(0, 1, At, B1); BAR;
      LDA(At, 1, 1); STAGE(SA(1, 0), A, brow, t + 3);
      BAR; WAIT_L(0); MMA(1, 0, At, B0); BAR; SCHED;
      STAGE(SB(1, 1), Bt, bcol + G_HALF, t + 3);
      WAIT_V(6); BAR; MMA(1, 1, At, B1); BAR;
    }
    { LDB(B0, 0, 0); LDA(At, 0, 0); STAGE(SA(1, 1), A, brow + G_HALF, nt - 1);
      BAR; WAIT_L(0); MMA(0, 0, At, B0); BAR;
      LDB(B1, 0, 1); BAR; WAIT_L(0); MMA(0, 1, At, B1); BAR;
      LDA(At, 0, 1); WAIT_V(4); BAR; WAIT_L(0); MMA(1, 0, At, B0); MMA(1, 1, At, B1); BAR; }
    { LDB(B0, 1, 0); LDA(At, 1, 0); WAIT_V(2); BAR; WAIT_L(0); MMA(0, 0, At, B0); BAR;
      LDB(B1, 1, 1); WAIT_V(0); BAR; WAIT_L(0); MMA(0, 1, At, B1); BAR;
      LDA(At, 1, 1); BAR; WAIT_L(0); MMA(1, 0, At, B0); MMA(1, 1, At, B1); BAR; }
    if (wr == 0) BAR;
    { const int tid_e = ltid(); const int wid = tid_e >> 6, lane = tid_e & 63, wr = wid >> 2, wc = wid & 3, fr = lane & 15, fq = lane >> 4;
#pragma unroll
    for (int ai = 0; ai < 2; ++ai)
#pragma unroll
      for (int bj = 0; bj < 2; ++bj)
#pragma unroll
        for (int m = 0; m < 4; ++m) {
          __builtin_amdgcn_sched_barrier(0);
          const int row = brow + ai * G_HALF + wr * 64 + m * 16 + fr;
          const int colb = bcol + bj * G_HALF + wc * 32 + fq * 4;
          if (MODE == EPI_RES) {
            float* hp0 = ea.f0 + (size_t)row * DM + colb;
            const float* hr0 = ea.fin + (size_t)row * DM + colb;
            float4 h0 = *(const float4*)hr0, h1 = *(const float4*)(hr0 + 16);
            if (ea.lng) {
              const float4 g0 = *(const float4*)(ea.lng + colb), g1 = *(const float4*)(ea.lng + colb + 16);
              const float4 b0 = *(const float4*)(ea.lnb + colb), b1 = *(const float4*)(ea.lnb + colb + 16);
              const float2 st = *(const float2*)(ea.stats + (size_t)row * 2);
              h0.x = (h0.x - st.x) * st.y * g0.x + b0.x; h0.y = (h0.y - st.x) * st.y * g0.y + b0.y;
              h0.z = (h0.z - st.x) * st.y * g0.z + b0.z; h0.w = (h0.w - st.x) * st.y * g0.w + b0.w;
              h1.x = (h1.x - st.x) * st.y * g1.x + b1.x; h1.y = (h1.y - st.x) * st.y * g1.y + b1.y;
              h1.z = (h1.z - st.x) * st.y * g1.z + b1.z; h1.w = (h1.w - st.x) * st.y * g1.w + b1.w;
            }
            const f32x4 a0 = acc[ai][bj][m][0], a1 = acc[ai][bj][m][1];
            float4 o0, o1;
            o0.x = ALPHA * h0.x + ea.scale * a0[0]; o0.y = ALPHA * h0.y + ea.scale * a0[1]; o0.z = ALPHA * h0.z + ea.scale * a0[2]; o0.w = ALPHA * h0.w + ea.scale * a0[3];
            o1.x = ALPHA * h1.x + ea.scale * a1[0]; o1.y = ALPHA * h1.y + ea.scale * a1[1]; o1.z = ALPHA * h1.z + ea.scale * a1[2]; o1.w = ALPHA * h1.w + ea.scale * a1[3];
            *(float4*)hp0 = o0; *(float4*)(hp0 + 16) = o1;
          } else if (MODE == EPI_FFN1) {
            const f32x4 gv = acc[ai][bj][m][0], uv = acc[ai][bj][m][1];
            const int jj = (bcol + bj * G_HALF + wc * 32) / 2 + fq * 4;
            uint2 pk;
            pk.x = pack2(silu_f(gv[0]) * uv[0], silu_f(gv[1]) * uv[1]);
            pk.y = pack2(silu_f(gv[2]) * uv[2], silu_f(gv[3]) * uv[3]);
            *(uint2*)(ea.cb + (size_t)row * DFF + jj) = pk;
          } else {
#pragma unroll
            for (int n = 0; n < 2; ++n) {
              const int col = colb + n * 16;
              const f32x4 v = acc[ai][bj][m][n];
              if (MODE == EPI_HYBIN) {
                if (col < HYB_IN_N) {
                  uint2 pk; pk.x = pack2(v[0], v[1]); pk.y = pack2(v[2], v[3]);
                  *(uint2*)(ea.cb + (size_t)row * HYB_IN_N + col) = pk;
                  if (col >= 3072 && col < 3088) *(float4*)(ea.f0 + (size_t)row * 16 + col - 3072) = make_float4(v[0], v[1], v[2], v[3]);
                  if (col >= 5648) *(float4*)(ea.f1 + (size_t)row * 16 + col - 5648) = make_float4(v[0], v[1], v[2], v[3]);
                }
              } else if (MODE == EPI_NSAIN) {
                if (col < NSA_IN_N) {
                  uint2 pk; pk.x = pack2(v[0], v[1]); pk.y = pack2(v[2], v[3]);
                  *(uint2*)(ea.cb + (size_t)row * NSA_IN_N + col) = pk;
                  if (col >= 1792) *(float4*)(ea.f0 + (size_t)row * 48 + col - 1792) = make_float4(sigmoid_acc(v[0]), sigmoid_acc(v[1]), sigmoid_acc(v[2]), sigmoid_acc(v[3]));
                }
              } else if (MODE == EPI_SILU) {
                uint2 pk; pk.x = pack2(silu_f(v[0]), silu_f(v[1])); pk.y = pack2(silu_f(v[2]), silu_f(v[3]));
                *(uint2*)(ea.cb + (size_t)row * ea.ldc + col) = pk;
              } else {
                if (col < ea.nvalid) { uint2 pk; pk.x = pack2(v[0], v[1]); pk.y = pack2(v[2], v[3]); *(uint2*)(ea.cb + (size_t)row * ea.ldc + col) = pk; }
              }
            }
          }
        }
    }
    WAIT_V(0);
    __syncthreads();
  }
#undef SA
#undef SB
#undef STAGE
#undef LDA
#undef LDB
#undef MMA
}

DI void hyb_prep(const Params p, int li) {
  const int wv_ = p.wave;
  const u16* proj = (const u16*)(p.ws + OFF_PROJ);
  const float* glog = (const float*)(p.ws + OFF_GLOG);
  const float* sdtl = (const float*)(p.ws + OFF_SDTL);
  u16* GQ = (u16*)(p.ws + OFF_GQ); u16* GK = (u16*)(p.ws + OFF_GK); u16* GV = (u16*)(p.ws + OFF_GV);
  float* GA = (float*)(p.ws + OFF_GA); float* GB = (float*)(p.ws + OFF_GB);
  u16* SX = (u16*)(p.ws + OFF_SX); u16* SB = (u16*)(p.ws + OFF_SB); u16* SC = (u16*)(p.ws + OFF_SC);
  float* SDT = (float*)(p.ws + OFF_SDT); float* SDA = (float*)(p.ws + OFF_SDA);
  const float* gcw = p.gdn_conv_w + (size_t)li * 4 * 2048;
  const float* scw = p.ssd_conv_w + (size_t)li * 4 * 1536;
  const float* scb = p.ssd_conv_b + (size_t)li * 1536;
  const int lane = ltid() & 63;
  XCD_AFF_DECL;
  const int wave = xa_on ? xa_slot : ((lbid() * NTHREADS + ltid()) >> 6), nw = xa_on ? xa_wpx : (int)gridDim.x * (NTHREADS / 64);
  const int rbase = xa_on ? xa_x * (M_TOK / 32) : 0, rcnt = xa_on ? M_TOK / 32 : M_TOK / 4;
  for (int rr = wave; rr < rcnt; rr += nw) {
    const int tb = rbase + rr;
    const int tok0 = tb * 4;
    const int t0 = tok0 & (T_SEQ - 1);
#pragma unroll 2
    for (int grp = 0; grp < 28; ++grp) {
      const bool isg = grp < 16;
      const int ch = (isg ? grp : grp - 16) * 128 + lane * 2;
      const int col = (isg ? 0 : 4112) + ch;
      const float* cw = isg ? gcw : scw;
      const int C = isg ? 2048 : 1536;
      unsigned xr[7];
#pragma unroll
      for (int r = 0; r < 7; ++r) {
        xr[r] = 0u;
        if (t0 - 3 + r >= 0) xr[r] = *(const unsigned*)(proj + (size_t)(tok0 - 3 + r) * HYB_IN_N + col);
      }
      float2 wv[4];
#pragma unroll
      for (int j = 0; j < 4; ++j) wv[j] = *(const float2*)(cw + j * C + ch);
      float b0 = 0.f, b1 = 0.f;
      if (!isg) { b0 = scb[ch]; b1 = scb[ch + 1]; }
      float y0[4], y1[4];
#pragma unroll
      for (int o = 0; o < 4; ++o) {
        float a0 = b0, a1 = b1;
#pragma unroll
        for (int j = 0; j < 4; ++j) { a0 += wv[j].x * bf2f((u16)(xr[o + j] & 0xffff)); a1 += wv[j].y * bf2f((u16)(xr[o + j] >> 16)); }
        y0[o] = silu_f(a0); y1[o] = silu_f(a1);
      }
      if (grp < 8) {
#pragma unroll
        for (int o = 0; o < 4; ++o) {
          float ss = wave_sum(y0[o] * y0[o] + y1[o] * y1[o]);
          float r = rsqrtf(ss + 1e-6f);
          if (grp < 4) r *= 0.08838834764831845f;
          u16* dst = (grp < 4 ? GQ : GK) + (size_t)(tok0 + o) * 512 + (grp & 3) * 128 + lane * 2;
          *(unsigned*)dst = pack2(y0[o] * r, y1[o] * r);
        }
      } else if (grp < 16) {
#pragma unroll
        for (int o = 0; o < 4; ++o) *(unsigned*)(GV + (size_t)(tok0 + o) * 1024 + (grp - 8) * 128 + lane * 2) = pack2(y0[o], y1[o]);
      } else {
#pragma unroll
        for (int o = 0; o < 4; ++o) {
          const size_t tk = tok0 + o;
          if (ch < 1024) *(unsigned*)(SX + tk * 1024 + ch) = pack2(y0[o], y1[o]);
          else if (ch < 1280) *(unsigned*)(SB + tk * 256 + ch - 1024) = pack2(y0[o], y1[o]);
          else *(unsigned*)(SC + tk * 256 + ch - 1280) = pack2(y0[o], y1[o]);
        }
      }
    }
    if (lane < 32) {
      const int o = lane >> 3, hd = lane & 7;
      const size_t tk = tok0 + o;
      float bl = glog[tk * 16 + hd], al_ = glog[tk * 16 + 8 + hd];
      GB[tk * 8 + hd] = sigmoid_acc(bl);
      float g = -expf(p.gdn_a_log[li * 8 + hd]) * softplus_acc(al_ + p.gdn_dt_bias[li * 8 + hd]);
      GA[tk * 8 + hd] = expf(g);
    }
    {
      const int o = lane >> 4, hd = lane & 15;
      const size_t tk = tok0 + o;
      float dt = softplus_acc(sdtl[tk * 16 + hd] + p.ssd_dt_bias[li * 16 + hd]);
      SDT[tk * 16 + hd] = dt;
      SDA[tk * 16 + hd] = expf(-expf(p.ssd_a_log[li * 16 + hd]) * dt);
    }
  }
}

DI void scan_item(const Params p, int li, int item, char* smem) {
  const int wv_ = p.wave;
  const int b = item >> 5, hv = (item >> 2) & 7, sl = item & 3, kh = hv >> 1;
  const int hd = (item >> 1) & 15, half = item & 1, sg = hd >> 3;
  const u16* GQ = (const u16*)(p.ws + OFF_GQ); const u16* GK = (const u16*)(p.ws + OFF_GK);
  u16* GV = (u16*)(p.ws + OFF_GV);
  const float* GA = (const float*)(p.ws + OFF_GA); const float* GB = (const float*)(p.ws + OFF_GB);
  u16* SX = (u16*)(p.ws + OFF_SX);
  const u16* SBg = (const u16*)(p.ws + OFF_SB); const u16* SCg = (const u16*)(p.ws + OFF_SC);
  const float* SDT = (const float*)(p.ws + OFF_SDT); const float* SDA = (const float*)(p.ws + OFF_SDA);
  const float dsk = p.ssd_d[li * 16 + hd];
  float* sk = (float*)smem;
  float* sq = sk + 32 * 192;
  float* sBm = sq + 32 * 192;
  float* sCm = sBm + 32 * 192;
  float* sv = sCm + 32 * 192;
  float* sx = sv + 32 * 32;
  float* sa = sx + 32 * 32;
  float* so_ = sa + 128;
  float* sy_ = so_ + 32 * 32;
  const int tid = ltid(), lane = tid & 63, w = tid >> 6;
  const int c = lane >> 4, ks = lane & 15, col = w * 4 + c;
  v2f S2[4], H2[4];
#pragma unroll
  for (int i = 0; i < 4; ++i) { S2[i] = v2f{0.f, 0.f}; H2[i] = v2f{0.f, 0.f}; }
  float4 rk0, rk1, rq0, rq1, rb0, rb1, rc0, rc1, rvx;
  float rs0 = 0.f, rs1 = 0.f;
  const int st_tk0 = tid >> 5, st_f4 = tid & 31;
  const int t2 = tid & 255, st_tk = t2 >> 3, st_f = t2 & 7;
#define SCAN_LOAD(chunk_) do { const size_t tok0_ = (size_t)b * T_SEQ + (chunk_) * 32; \
      rk0 = ld4bf(GK + (tok0_ + st_tk0) * 512 + kh * 128 + st_f4 * 4); \
      rq0 = ld4bf(GQ + (tok0_ + st_tk0) * 512 + kh * 128 + st_f4 * 4); \
      rb0 = ld4bf(SBg + (tok0_ + st_tk0) * 256 + sg * 128 + st_f4 * 4); \
      rc0 = ld4bf(SCg + (tok0_ + st_tk0) * 256 + sg * 128 + st_f4 * 4); \
      rk1 = ld4bf(GK + (tok0_ + st_tk0 + 16) * 512 + kh * 128 + st_f4 * 4); \
      rq1 = ld4bf(GQ + (tok0_ + st_tk0 + 16) * 512 + kh * 128 + st_f4 * 4); \
      rb1 = ld4bf(SBg + (tok0_ + st_tk0 + 16) * 256 + sg * 128 + st_f4 * 4); \
      rc1 = ld4bf(SCg + (tok0_ + st_tk0 + 16) * 256 + sg * 128 + st_f4 * 4); \
    if (tid < 256) rvx = ld4bf(GV + (tok0_ + st_tk) * 1024 + hv * 128 + sl * 32 + st_f * 4); \
    else rvx = ld4bf(SX + (tok0_ + st_tk) * 1024 + hd * 64 + half * 32 + st_f * 4); \
    if (tid < 32) { rs0 = GA[(tok0_ + tid) * 8 + hv]; rs1 = GB[(tok0_ + tid) * 8 + hv]; } \
    else if (tid < 64) { rs0 = SDT[(tok0_ + tid - 32) * 16 + hd]; rs1 = SDA[(tok0_ + tid - 32) * 16 + hd]; } } while (0)
  SCAN_LOAD(0);
  for (int chunk = 0; chunk < T_SEQ / 32; ++chunk) {
    const size_t tok0 = (size_t)b * T_SEQ + chunk * 32;
    __syncthreads();
    {
      const int lo = st_tk0 * 192 + (st_f4 >> 1) * 12 + (st_f4 & 1) * 4;
      *(float4*)(sk + lo) = rk0; *(float4*)(sq + lo) = rq0; *(float4*)(sBm + lo) = rb0; *(float4*)(sCm + lo) = rc0;
      *(float4*)(sk + lo + 16 * 192) = rk1; *(float4*)(sq + lo + 16 * 192) = rq1; *(float4*)(sBm + lo + 16 * 192) = rb1; *(float4*)(sCm + lo + 16 * 192) = rc1;
    }
    if (tid < 256) *(float4*)(sv + st_tk * 32 + st_f * 4) = rvx; else *(float4*)(sx + st_tk * 32 + st_f * 4) = rvx;
    if (tid < 32) { sa[tid] = rs0; sa[32 + tid] = rs1; }
    else if (tid < 64) { sa[64 + tid - 32] = rs0; sa[96 + tid - 32] = rs1; }
    __syncthreads();
    if (chunk + 1 < T_SEQ / 32) SCAN_LOAD(chunk + 1);
    const float* pk = sk + ks * 12; const float* pq = sq + ks * 12; const float* pb = sBm + ks * 12; const float* pc = sCm + ks * 12;
    float4 nk0 = *(const float4*)(pk), nk1 = *(const float4*)(pk + 4), nq0 = *(const float4*)(pq), nq1 = *(const float4*)(pq + 4);
    float4 nb0 = *(const float4*)(pb), nb1 = *(const float4*)(pb + 4), nc0 = *(const float4*)(pc), nc1 = *(const float4*)(pc + 4);
    float na = sa[0], nbt = sa[32], ndt = sa[64], nda = sa[96], nv = sv[col], nx = sx[col];
#pragma unroll 2
    for (int tt = 0; tt < 32; ++tt) {
      const float4 k0 = nk0, k1 = nk1, q0 = nq0, q1 = nq1, b0 = nb0, b1 = nb1, c0 = nc0, c1 = nc1;
      const float a = na, bt = nbt, dt = ndt, da = nda, v = nv, xv = nx;
      if (tt + 1 < 32) {
        const int o = (tt + 1) * 192;
        nk0 = *(const float4*)(pk + o); nk1 = *(const float4*)(pk + o + 4); nq0 = *(const float4*)(pq + o); nq1 = *(const float4*)(pq + o + 4);
        nb0 = *(const float4*)(pb + o); nb1 = *(const float4*)(pb + o + 4); nc0 = *(const float4*)(pc + o); nc1 = *(const float4*)(pc + o + 4);
        na = sa[tt + 1]; nbt = sa[33 + tt]; ndt = sa[65 + tt]; nda = sa[97 + tt]; nv = sv[(tt + 1) * 32 + col]; nx = sx[(tt + 1) * 32 + col];
      }
      const v2f kk0 = {k0.x, k0.y}, kk1 = {k0.z, k0.w}, kk2 = {k1.x, k1.y}, kk3 = {k1.z, k1.w};
      const v2f qa0 = {q0.x, q0.y}, qa1 = {q0.z, q0.w}, qa2 = {q1.x, q1.y}, qa3 = {q1.z, q1.w};
      v2f dacc = S2[0] * kk0; dacc = S2[1] * kk1 + dacc; dacc = S2[2] * kk2 + dacc; dacc = S2[3] * kk3 + dacc;
      const float dot = red16(dacc.x + dacc.y);
      const float d = bt * (v - a * dot);
      const v2f dd = {d, d}, aa = {a, a};
      S2[0] = aa * S2[0] + kk0 * dd; S2[1] = aa * S2[1] + kk1 * dd; S2[2] = aa * S2[2] + kk2 * dd; S2[3] = aa * S2[3] + kk3 * dd;
      v2f oacc = S2[0] * qa0; oacc = S2[1] * qa1 + oacc; oacc = S2[2] * qa2 + oacc; oacc = S2[3] * qa3 + oacc;
      const float o = red16(oacc.x + oacc.y);
      const float xdt = xv * dt;
      const v2f xx = {xdt, xdt}, dda = {da, da};
      const v2f bb0 = {b0.x, b0.y}, bb1 = {b0.z, b0.w}, bb2 = {b1.x, b1.y}, bb3 = {b1.z, b1.w};
      const v2f cc0 = {c0.x, c0.y}, cc1 = {c0.z, c0.w}, cc2 = {c1.x, c1.y}, cc3 = {c1.z, c1.w};
      H2[0] = H2[0] * dda + xx * bb0; H2[1] = H2[1] * dda + xx * bb1; H2[2] = H2[2] * dda + xx * bb2; H2[3] = H2[3] * dda + xx * bb3;
      v2f yacc = H2[0] * cc0; yacc = H2[1] * cc1 + yacc; yacc = H2[2] * cc2 + yacc; yacc = H2[3] * cc3 + yacc;
      const float y = red16(yacc.x + yacc.y);
      if (ks == 0) { so_[tt * 32 + col] = o; sy_[tt * 32 + col] = y + dsk * xv; }
    }
    __syncthreads();
    {
      const int t2 = tid & 255, tk = t2 >> 3, f4 = t2 & 7;
      if (tid < 256) st4bf(GV + (tok0 + tk) * 1024 + hv * 128 + sl * 32 + f4 * 4, *(const float4*)(so_ + tk * 32 + f4 * 4));
      else st4bf(SX + (tok0 + tk) * 1024 + hd * 64 + half * 32 + f4 * 4, *(const float4*)(sy_ + tk * 32 + f4 * 4));
    }
  }
}

DI void hyb_post(const Params p, int li) {
  const int wv_ = p.wave;
  const u16* proj = (const u16*)(p.ws + OFF_PROJ);
  const u16* GV = (const u16*)(p.ws + OFF_GV);
  const u16* SX = (const u16*)(p.ws + OFF_SX);
  u16* O = (u16*)(p.ws + OFF_O);
  const float* gnw = p.gdn_norm_w + li * 128;
  const float* snw = p.ssd_norm_w + li * 1024;
  const int lane = ltid() & 63;
  XCD_AFF_DECL;
  const int wave = xa_on ? xa_slot : ((lbid() * NTHREADS + ltid()) >> 6), nw = xa_on ? xa_wpx : (int)gridDim.x * (NTHREADS / 64);
  const int rbase = xa_on ? xa_x * (M_TOK / 8) : 0, rcnt = xa_on ? M_TOK / 8 : M_TOK;
  for (int rr = wave; rr < rcnt; rr += nw) {
    const int tok = rbase + rr;
    float2 ov[8]; unsigned zg[8];
#pragma unroll
    for (int hv = 0; hv < 8; ++hv) {
      { const unsigned u_ = *(const unsigned*)(GV + (size_t)tok * 1024 + hv * 128 + lane * 2); ov[hv] = make_float2(__uint_as_float(u_ << 16), __uint_as_float(u_ & 0xffff0000u)); }
      zg[hv] = *(const unsigned*)(proj + (size_t)tok * HYB_IN_N + 2048 + hv * 128 + lane * 2);
    }
    float4 ya[2], yb[2]; uint4 zs[2];
#pragma unroll
    for (int grp = 0; grp < 2; ++grp) {
      const int ch = grp * 512 + lane * 8;
      ya[grp] = ld4bf(SX + (size_t)tok * 1024 + ch);
      yb[grp] = ld4bf(SX + (size_t)tok * 1024 + ch + 4);
      zs[grp] = *(const uint4*)(proj + (size_t)tok * HYB_IN_N + 3088 + ch);
    }
    const float2 nwv = *(const float2*)(gnw + lane * 2);
#pragma unroll
    for (int hv = 0; hv < 8; ++hv) {
      const float2 o = ov[hv];
      float ss = wave_sum(o.x * o.x + o.y * o.y);
      float r = rsqrtf(ss * (1.f / 128.f) + 1e-6f);
      float z0 = bf2f((u16)(zg[hv] & 0xffff)), z1 = bf2f((u16)(zg[hv] >> 16));
      *(unsigned*)(O + (size_t)tok * 2048 + hv * 128 + lane * 2) = pack2(o.x * r * nwv.x * silu_f(z0), o.y * r * nwv.y * silu_f(z1));
    }
#pragma unroll
    for (int grp = 0; grp < 2; ++grp) {
      const int ch = grp * 512 + lane * 8;
      float yy[8] = {ya[grp].x, ya[grp].y, ya[grp].z, ya[grp].w, yb[grp].x, yb[grp].y, yb[grp].z, yb[grp].w};
      unsigned zz[4] = {zs[grp].x, zs[grp].y, zs[grp].z, zs[grp].w};
      float ss = 0.f;
#pragma unroll
      for (int j = 0; j < 8; ++j) {
        float z = bf2f((u16)((zz[j >> 1] >> ((j & 1) * 16)) & 0xffff));
        yy[j] *= silu_f(z); ss += yy[j] * yy[j];
      }
      ss = wave_sum(ss);
      float r = rsqrtf(ss * (1.f / 512.f) + 1e-6f);
      float4 w0 = *(const float4*)(snw + ch), w1 = *(const float4*)(snw + ch + 4);
      uint4 ovv;
      ovv.x = pack2(yy[0] * r * w0.x, yy[1] * r * w0.y); ovv.y = pack2(yy[2] * r * w0.z, yy[3] * r * w0.w);
      ovv.z = pack2(yy[4] * r * w1.x, yy[5] * r * w1.y); ovv.w = pack2(yy[6] * r * w1.z, yy[7] * r * w1.w);
      *(uint4*)(O + (size_t)tok * 2048 + 1024 + ch) = ovv;
    }
  }
}

DI void nsa_prep(const Params p, int li) {
  const int wv_ = p.wave;
  const u16* proj = (const u16*)(p.ws + OFF_PROJ);
  u16* QROT = (u16*)(p.ws + OFF_QROT); u16* KSR = (u16*)(p.ws + OFF_KSR); u16* KWR = (u16*)(p.ws + OFF_KWR);
  u16* FLATK = (u16*)(p.ws + OFF_FLATK); u16* FLATV = (u16*)(p.ws + OFF_FLATV);
  const float* cpos = p.nsa_cmp_pos + (size_t)li * 2 * 32 * 64;
  const float INVF[8] = {1.0f, 0.1939227432012558f, 0.03760603070259094f, 0.007292664609849453f, 0.0014142135623842478f,
                         0.00027424818836152554f, 5.3182957344688475e-05f, 1.0313385246263351e-05f};
  const int lane = ltid() & 63;
  XCD_AFF_DECL;
  const int wave = xa_on ? xa_slot : ((lbid() * NTHREADS + ltid()) >> 6), nw = xa_on ? xa_wpx : (int)gridDim.x * (NTHREADS / 64);
  const int rbase = xa_on ? xa_x * (M_TOK / 8) : 0, rcnt = xa_on ? M_TOK / 8 : M_TOK;
  for (int rr = wave; rr < rcnt; rr += nw) {
    const int tok = rbase + rr;
    const int t = tok & (T_SEQ - 1), b = tok >> 11;
    const float pf = (float)p.pos[tok];
    const int fi = lane & 7;
    float invf = INVF[0];
#pragma unroll
    for (int i = 1; i < 8; ++i) if (fi == i) invf = INVF[i];
    float sn, cs;
    sincosf(pf * invf, &sn, &cs);
    const u16* pr = proj + (size_t)tok * NSA_IN_N;
#pragma unroll
    for (int r = 0; r < 2; ++r) {
      const int pi = lane + 64 * r, hd = pi >> 3;
      float x1 = bf2f(pr[hd * 64 + fi]), x2 = bf2f(pr[hd * 64 + 8 + fi]);
      QROT[((size_t)tok * 16 + hd) * 16 + fi] = f2bf(x1 * cs - x2 * sn);
      QROT[((size_t)tok * 16 + hd) * 16 + 8 + fi] = f2bf(x2 * cs + x1 * sn);
    }
#pragma unroll
    for (int r = 0; r < 2; ++r) {
      const int cbase = r == 0 ? 1280 : 1536;
      u16* dst = (r == 0 ? KSR : KWR) + (size_t)tok * 128;
      if (lane < 16) {
        const int gg = lane >> 3;
        float x1 = bf2f(pr[cbase + gg * 64 + fi]), x2 = bf2f(pr[cbase + gg * 64 + 8 + fi]);
        dst[gg * 64 + fi] = f2bf(x1 * cs - x2 * sn);
        dst[gg * 64 + 8 + fi] = f2bf(x2 * cs + x1 * sn);
      }
      for (int e = lane; e < 96; e += 64) {
        const int gg = e / 48, d = 16 + e % 48;
        dst[gg * 64 + d] = pr[cbase + gg * 64 + d];
      }
    }
    {
      const int gg = lane >> 5, d = (lane & 31) * 2;
      unsigned kv = *(const unsigned*)(pr + 1024 + gg * 64 + d);
      unsigned vv = *(const unsigned*)(pr + 1152 + gg * 64 + d);
      const float k0 = bf2f((u16)(kv & 0xffff)), k1 = bf2f((u16)(kv >> 16));
      const float v0 = bf2f((u16)(vv & 0xffff)), v1 = bf2f((u16)(vv >> 16));
#pragma unroll
      for (int r = 0; r < 2; ++r) {
        const int c = (t >> 4) - 1 + r;
        const int j = t - 16 * c;
        if (c >= 0 && c < 127) {
          const size_t row = ((size_t)b * 127 + c) * 2 + gg;
          float2 pk = *(const float2*)(cpos + (0 * 32 + j) * 64 + d);
          float2 pv = *(const float2*)(cpos + (1 * 32 + j) * 64 + d);
          *(unsigned*)(FLATK + row * 2048 + j * 64 + d) = pack2(k0 + pk.x, k1 + pk.y);
          *(unsigned*)(FLATV + row * 2048 + j * 64 + d) = pack2(v0 + pv.x, v1 + pv.y);
        }
      }
    }
  }
}

using u32x4 = __attribute__((ext_vector_type(4))) unsigned;
DI bf16x8 pack8(const f32x16& x, int s2) {
  u32x4 r;
#pragma unroll
  for (int j = 0; j < 4; ++j) r[j] = pack2(x[8 * s2 + 2 * j], x[8 * s2 + 2 * j + 1]);
  return __builtin_bit_cast(bf16x8, r);
}

DI void nsa_attn_item(const Params p, int item, int flip, char* smem) {
  const int wv_ = p.wave;
  const int tile0 = item & 63, g = (item >> 6) & 1, b = item >> 7;
  const int tile = flip ? 63 - tile0 : tile0;
  const int t0 = tile * 32, cur = t0 >> 6;
  const u16* proj = (const u16*)(p.ws + OFF_PROJ);
  const float* GATES = (const float*)(p.ws + OFF_NGATE);
  const u16* QROT = (const u16*)(p.ws + OFF_QROT);
  const u16* KSR = (const u16*)(p.ws + OFF_KSR); const u16* KWR = (const u16*)(p.ws + OFF_KWR);
  const u16* KCMP = (const u16*)(p.ws + OFF_KCMP); const u16* VCMP = (const u16*)(p.ws + OFF_VCMP);
  u16* NO = (u16*)(p.ws + OFF_NO);
  u16* sK = (u16*)smem;
  u16* sVt = sK + 128 * 72;
  float* simp = (float*)(sVt + 64 * 136);
  unsigned* smask = (unsigned*)(simp + 32 * 33);
  const int tid = ltid(), lane = tid & 63, w = tid >> 6;
  const int l31 = lane & 31, hh = lane >> 5;
  const int tq = t0 + l31;
  const size_t tokq = (size_t)b * T_SEQ + tq;
  const float NEG_INF = -__builtin_huge_valf();
  const float SM_C = 0.125f * 1.4426950408889634f;
  const int head = g * 8 + w;

  __syncthreads();
  for (int i = tid; i < 32 * 33; i += NTHREADS) simp[i] = 0.f;
#pragma unroll
  for (int i = 0; i < 2; ++i) {
    {
      const int idx = tid + 512 * i, r = idx >> 3, c = idx & 7;
      uint4 kv = make_uint4(0, 0, 0, 0);
      if (r < 127) kv = *(const uint4*)(KCMP + (((size_t)b * 127 + r) * 2 + g) * 64 + c * 8);
      *(uint4*)(sK + r * 72 + c * 8) = kv;
    }
    {
      const int r = (tid & 63) + 64 * i, c = tid >> 6;
      uint4 vv = make_uint4(0, 0, 0, 0);
      if (r < 127) vv = *(const uint4*)(VCMP + (((size_t)b * 127 + r) * 2 + g) * 64 + c * 8);
      const unsigned vw[4] = {vv.x, vv.y, vv.z, vv.w};
#pragma unroll
      for (int j = 0; j < 8; ++j) sVt[(c * 8 + j) * 136 + r] = (u16)((vw[j >> 1] >> ((j & 1) * 16)) & 0xffff);
    }
  }
  __syncthreads();

  f32x16 otot[2];
  {
    bf16x8 qf[4];
#pragma unroll
    for (int ks = 0; ks < 4; ++ks) qf[ks] = *(const bf16x8*)(proj + tokq * NSA_IN_N + head * 64 + ks * 16 + hh * 8);
    const int cmax = (tq >= 31) ? ((tq - 31) >> 4) : -1;
    f32x16 s[4];
#pragma unroll
    for (int kt = 0; kt < 4; ++kt) {
#pragma unroll
      for (int i = 0; i < 16; ++i) s[kt][i] = 0.f;
#pragma unroll
      for (int ks = 0; ks < 4; ++ks) {
        bf16x8 a = *(const bf16x8*)(sK + (kt * 32 + l31) * 72 + ks * 16 + hh * 8);
        s[kt] = MFMA32(a, qf[ks], s[kt]);
      }
    }
    float mx = NEG_INF;
#pragma unroll
    for (int kt = 0; kt < 4; ++kt)
#pragma unroll
      for (int i = 0; i < 16; ++i) {
        const int c = kt * 32 + crow(i, hh);
        const float v = (c <= cmax) ? s[kt][i] : NEG_INF;
        s[kt][i] = v; mx = fmaxf(mx, v);
      }
    mx = fmaxf(mx, swap32(mx, lane)) * SM_C;
    const float msafe = (mx == NEG_INF) ? 0.f : mx;
    float sum = 0.f;
#pragma unroll
    for (int kt = 0; kt < 4; ++kt)
#pragma unroll
      for (int i = 0; i < 16; ++i) { const float e = __builtin_amdgcn_exp2f(__builtin_fmaf(s[kt][i], SM_C, -msafe)); s[kt][i] = e; sum += e; }
    sum += swap32(sum, lane);
    const float inv = 1.f / fmaxf(sum, 1e-30f);
#pragma unroll
    for (int kt = 0; kt < 4; ++kt)
#pragma unroll
      for (int i = 0; i < 16; ++i) s[kt][i] *= inv;
#pragma unroll
    for (int kt = 0; kt < 4; ++kt)
#pragma unroll
      for (int g4 = 0; g4 < 4; ++g4) {
        const int blk = 8 * kt + 2 * g4 + hh;
        const float p3 = s[kt][4 * g4 + 3];
        atomicAdd(&simp[l31 * 33 + blk], s[kt][4 * g4] + s[kt][4 * g4 + 1] + s[kt][4 * g4 + 2] + 0.5f * p3);
        if (blk + 1 < 32) atomicAdd(&simp[l31 * 33 + blk + 1], 0.5f * p3);
      }
    f32x16 oc[2];
#pragma unroll
    for (int dt = 0; dt < 2; ++dt)
#pragma unroll
      for (int i = 0; i < 16; ++i) oc[dt][i] = 0.f;
#pragma unroll
    for (int kt = 0; kt < 4; ++kt)
#pragma unroll
      for (int s2 = 0; s2 < 2; ++s2) {
        const bf16x8 pf = pack8(s[kt], s2);
#pragma unroll
        for (int dt = 0; dt < 2; ++dt) {
          const u16* vp = sVt + (dt * 32 + l31) * 136 + kt * 32 + 16 * s2 + 4 * hh;
          s16x4 lo = *(const s16x4*)vp, hi = *(const s16x4*)(vp + 8);
          bf16x8 vf = __builtin_shufflevector(lo, hi, 0, 1, 2, 3, 4, 5, 6, 7);
          oc[dt] = MFMA32(vf, pf, oc[dt]);
        }
      }
    const float gate = GATES[tokq * 48 + head * 3 + 0];
#pragma unroll
    for (int dt = 0; dt < 2; ++dt)
#pragma unroll
      for (int i = 0; i < 16; ++i) otot[dt][i] = gate * oc[dt][i];
  }
  __syncthreads();
  {
    const int tkn = tid >> 4, l16 = tid & 15;
    float sc0, sc1;
    {
      const int j0 = l16, j1 = l16 + 16;
      const bool c0 = j0 <= cur, c1 = j1 <= cur;
      const bool f0 = (j0 == 0) || (c0 && j0 > cur - 2), f1 = c1 && j1 > cur - 2;
      sc0 = f0 ? 1e4f : (c0 ? simp[tkn * 33 + j0] : -1.f);
      sc1 = f1 ? 1e4f : (c1 ? simp[tkn * 33 + j1] : -1.f);
    }
    unsigned sel = 0;
#pragma unroll 1
    for (int r = 0; r < 8; ++r) {
      float bv; int bj;
      if (sc0 >= sc1) { bv = sc0; bj = l16; } else { bv = sc1; bj = l16 + 16; }
#define TOPK_STEP(ctrl) { const float ov = __int_as_float(__builtin_amdgcn_update_dpp(0, __float_as_int(bv), (ctrl), 0xF, 0xF, false)); \
        const int oj = __builtin_amdgcn_update_dpp(0, bj, (ctrl), 0xF, 0xF, false); \
        if (ov > bv || (ov == bv && oj < bj)) { bv = ov; bj = oj; } }
      TOPK_STEP(0xB1) TOPK_STEP(0x4E) TOPK_STEP(0x141) TOPK_STEP(0x140)
      sel |= 1u << bj;
      if (bj == l16) sc0 = NEG_INF;
      if (bj == l16 + 16) sc1 = NEG_INF;
    }
    if (cur < 31) sel &= (1u << (cur + 1)) - 1u;
    if (l16 == 0) smask[tkn] = sel;
  }
  __syncthreads();
  const unsigned mymask = smask[l31];
  unsigned uni = 0;
  for (int i = 0; i < 32; ++i) uni |= smask[i];

  bf16x8 qq[4];
  qq[0] = *(const bf16x8*)(QROT + (tokq * 16 + head) * 16 + hh * 8);
#pragma unroll
  for (int ks = 1; ks < 4; ++ks) qq[ks] = *(const bf16x8*)(proj + tokq * NSA_IN_N + head * 64 + ks * 16 + hh * 8);
  {
    const int jlo = (t0 - 511 > 0 ? t0 - 511 : 0) >> 6;
    const int nsel = __popc(uni), ntile = nsel + (cur - jlo + 1);
    unsigned rem = uni;
    float mrun = NEG_INF, lrun = 0.f;
    f32x16 oa[2];
#pragma unroll
    for (int dt = 0; dt < 2; ++dt)
#pragma unroll
      for (int i = 0; i < 16; ++i) oa[dt][i] = 0.f;
    const int kr = tid >> 3, kc = tid & 7, vr = tid & 63, vc = tid >> 6;
    uint4 pk, pv;
    int nj, nbr;
    { nj = __ffs(rem) - 1; rem &= rem - 1; nbr = 0;
      pk = *(const uint4*)(KSR + (((size_t)b * T_SEQ + nj * 64 + kr) * 2 + g) * 64 + kc * 8);
      pv = *(const uint4*)(proj + ((size_t)b * T_SEQ + nj * 64 + vr) * NSA_IN_N + 1408 + g * 64 + vc * 8); }
#pragma unroll 1
    for (int it = 0; it < ntile; ++it) {
      const int j = nj, br = nbr;
      __syncthreads();
      *(uint4*)(sK + kr * 72 + kc * 8) = pk;
      {
        const unsigned vw[4] = {pv.x, pv.y, pv.z, pv.w};
#pragma unroll
        for (int jj = 0; jj < 8; ++jj) sVt[(vc * 8 + jj) * 136 + vr] = (u16)((vw[jj >> 1] >> ((jj & 1) * 16)) & 0xffff);
      }
      __syncthreads();
      if (it + 1 < ntile) {
        if (it + 1 < nsel) { nj = __ffs(rem) - 1; rem &= rem - 1; nbr = 0; } else { nj = jlo + it + 1 - nsel; nbr = 1; }
        const u16* Kg = nbr ? KWR : KSR;
        const int vcol = nbr ? 1664 : 1408;
        pk = *(const uint4*)(Kg + (((size_t)b * T_SEQ + nj * 64 + kr) * 2 + g) * 64 + kc * 8);
        pv = *(const uint4*)(proj + ((size_t)b * T_SEQ + nj * 64 + vr) * NSA_IN_N + vcol + g * 64 + vc * 8);
      }
      if (it == nsel) {
        const float gate = GATES[tokq * 48 + head * 3 + 1];
        const float sc = gate / fmaxf(lrun, 1e-30f);
#pragma unroll
        for (int dt = 0; dt < 2; ++dt)
#pragma unroll
          for (int i = 0; i < 16; ++i) { otot[dt][i] += sc * oa[dt][i]; oa[dt][i] = 0.f; }
        mrun = NEG_INF; lrun = 0.f;
      }
      f32x16 s[2];
#pragma unroll
      for (int kt = 0; kt < 2; ++kt) {
#pragma unroll
        for (int i = 0; i < 16; ++i) s[kt][i] = 0.f;
        const u16* kp = sK + (kt * 32 + l31) * 72 + hh * 8;
#pragma unroll
        for (int ks = 0; ks < 4; ++ks) s[kt] = MFMA32(*(const bf16x8*)(kp + ks * 16), qq[ks], s[kt]);
      }
      const bool selbit = (mymask >> j) & 1u;
      const int klo = br ? tq - 512 : -1;
      const bool rowok = br ? true : selbit;
      float mx = NEG_INF;
      const bool fullvis = (j * 64 + 63 <= t0) && (br == 0 || j * 64 > t0 + 31 - 512);
      if (fullvis) {
        const float bias = rowok ? 0.f : NEG_INF;
#pragma unroll
        for (int kt = 0; kt < 2; ++kt)
#pragma unroll
          for (int i = 0; i < 16; ++i) { const float v = s[kt][i] + bias; s[kt][i] = v; mx = fmaxf(mx, v); }
      } else {
#pragma unroll
        for (int kt = 0; kt < 2; ++kt)
#pragma unroll
          for (int i = 0; i < 16; ++i) {
            const int key = j * 64 + kt * 32 + crow(i, hh);
            const bool ok = rowok && key <= tq && key > klo;
            const float v = ok ? s[kt][i] : NEG_INF;
            s[kt][i] = v; mx = fmaxf(mx, v);
          }
      }
      mx = fmaxf(mx, swap32(mx, lane)) * SM_C;
      const float mnew = fmaxf(mrun, mx);
      const float msafe = (mnew == NEG_INF) ? 0.f : mnew;
      const float alpha = __builtin_amdgcn_exp2f(mrun - msafe);
      float psum = 0.f;
#pragma unroll
      for (int kt = 0; kt < 2; ++kt)
#pragma unroll
        for (int i = 0; i < 16; ++i) { const float e = __builtin_amdgcn_exp2f(__builtin_fmaf(s[kt][i], SM_C, -msafe)); s[kt][i] = e; psum += e; }
      psum += swap32(psum, lane);
      lrun = lrun * alpha + psum;
      mrun = mnew;
#pragma unroll
      for (int dt = 0; dt < 2; ++dt)
#pragma unroll
        for (int i = 0; i < 16; ++i) oa[dt][i] *= alpha;
#pragma unroll
      for (int kt = 0; kt < 2; ++kt)
#pragma unroll
        for (int s2 = 0; s2 < 2; ++s2) {
          const bf16x8 pf = pack8(s[kt], s2);
#pragma unroll
          for (int dt = 0; dt < 2; ++dt) {
            const u16* vp = sVt + (dt * 32 + l31) * 136 + kt * 32 + 16 * s2 + 4 * hh;
            s16x4 lo = *(const s16x4*)vp, hi = *(const s16x4*)(vp + 8);
            bf16x8 vf = __builtin_shufflevector(lo, hi, 0, 1, 2, 3, 4, 5, 6, 7);
            oa[dt] = MFMA32(vf, pf, oa[dt]);
          }
        }
    }
    {
      const float gate = GATES[tokq * 48 + head * 3 + 2];
      const float sc = gate / fmaxf(lrun, 1e-30f);
#pragma unroll
      for (int dt = 0; dt < 2; ++dt)
#pragma unroll
        for (int i = 0; i < 16; ++i) otot[dt][i] += sc * oa[dt][i];
    }
  }
#pragma unroll
  for (int dt = 0; dt < 2; ++dt)
#pragma unroll
    for (int i = 0; i < 16; ++i) NO[tokq * 1024 + head * 64 + dt * 32 + crow(i, hh)] = f2bf(otot[dt][i]);
}

__constant__ unsigned char PROG[48] = {
  0x01,0x02,0x03,0x04,0x05,0x06,0x07,0x09,0x0a,0x0b,0x0c,0x0d,
  0x11,0x12,0x13,0x14,0x15,0x16,0x18,0x19,0x1a,0x1b,0x1c,0x1d,
  0x21,0x22,0x23,0x24,0x25,0x26,0x27,0x29,0x2a,0x2b,0x2c,0x2d,
  0x31,0x32,0x33,0x34,0x35,0x36,0x38,0x39,0x3a,0x3b,0x3c,0x3d};
constexpr int N_PHASES = 49;

DI void run_phase(const Params p, int ph, char* smem) {
  const int wv_ = p.wave;
  float* H = (float*)(p.ws + OFF_H);
  u16* HB = (u16*)(p.ws + OFF_HB);
  const int pcode = (ph == 0) ? 0 : (int)PROG[ph - 1];
  const int layer = pcode >> 4, step = pcode & 15;
  const int li = layer >> 1;
  const bool hyb = (layer & 1) == 0;
  u16* W_MIN = (u16*)(p.ws + OFF_W_MIN);
  u16* W_MOUT = (u16*)(p.ws + OFF_W_MOUT);
  u16* ACT = (u16*)(p.ws + OFF_ACT);
  if (ph == 0) init_phase(p.x, H, HB, wv_);
  else if (step == 3 || step == 10 || step == 13) {
    const int k = step == 3 ? 0 : (step == 10 ? 1 : 2);
    const bool last = (layer == 3 && step == 13);
    ln_phase(H, HB, p.ln_g + (size_t)(layer * 3 + k) * DM, p.ln_b + (size_t)(layer * 3 + k) * DM, last ? p.out : nullptr, (float*)(p.ws + OFF_STATS), wv_);
  }
  {
    int cset = -1, cl = layer;
    if (ph == 0) cset = 0;
    else if (step == 3) cset = 1;
    else if (step == 10) cset = 2;
    else if (step == 13 && layer < 3) { cset = 0; cl = layer + 1; }
    if (cset >= 0) {
      const bool chyb = (cl & 1) == 0; const int cli = cl >> 1;
      const int c0 = (cset == 1) ? 4 : 0, c1 = (cset == 1) ? (chyb ? 6 : 10) : 2;
#pragma unroll 1
      for (int cc = c0; cc < c1; ++cc) {
        const int sblk = (cset == 2) ? 1 : 0;
        const float* src; u16* dst; int K, N, Np, mode = 0;
        if (cset != 1 && cc == 0) { src = p.ffn_w_in + (size_t)(cl * 2 + sblk) * 1024 * 5632; dst = (u16*)(p.ws + OFF_W_FIN0 + sblk * SZ_W_FIN); K = 1024; N = 5632; Np = 5632; mode = 1; }
        else if (cset != 1) { src = p.ffn_w_out + (size_t)(cl * 2 + sblk) * 2816 * 1024; dst = (u16*)(p.ws + OFF_W_FOUT0 + sblk * SZ_W_FOUT); K = 2816; N = 1024; Np = 1024; }
        else if (cc == 4) { src = chyb ? p.hyb_w_in + (size_t)cli * 1024 * HYB_IN_N : p.nsa_w_in + (size_t)cli * 1024 * NSA_IN_N; dst = W_MIN; K = 1024; N = chyb ? HYB_IN_N : NSA_IN_N; Np = chyb ? HYB_IN_NP : NSA_IN_NP; }
        else if (cc == 5) { src = chyb ? p.hyb_w_out + (size_t)cli * 2048 * 1024 : p.nsa_w_out + (size_t)cli * 1024 * 1024; dst = W_MOUT; K = chyb ? 2048 : 1024; N = 1024; Np = 1024; }
        else if (cc < 8) { src = p.nsa_cmp_w1 + (size_t)(cli * 2 + cc - 6) * 2048 * 256; dst = (u16*)(p.ws + OFF_W_C1 + (cc - 6) * SZ_W_C1); K = 2048; N = 256; Np = 256; }
        else { src = p.nsa_cmp_w2 + (size_t)(cli * 2 + cc - 8) * 256 * 64; dst = (u16*)(p.ws + OFF_W_C2 + (cc - 8) * SZ_W_C2); K = 256; N = 64; Np = 256; }
        convT(src, dst, K, N, Np, mode, smem, wv_);
      }
    }
  }
  if (ph == 0) return;
  switch (step) {
    case 1: case 11: {
      EpiArgs ea{}; ea.cb = ACT;
      gemm_phase<EPI_FFN1>(HB, DM, (const u16*)(p.ws + OFF_W_FIN0 + (step == 1 ? 0 : 1) * SZ_W_FIN), M_TOK, 5632, 1024, ea, smem, wv_);
    } break;
    case 2: case 12: case 9: {
      EpiArgs ea{}; ea.f0 = H; ea.fin = (layer == 0 && step == 2) ? p.x : (const float*)H;
      {
        const int lnidx = (step == 2) ? (layer * 3 - 1) : (step == 9 ? layer * 3 : layer * 3 + 1);
        if (lnidx >= 0) { ea.lng = p.ln_g + (size_t)lnidx * DM; ea.lnb = p.ln_b + (size_t)lnidx * DM; ea.stats = (const float*)(p.ws + OFF_STATS); }
      }
      const u16* Ap; const u16* Wp; int lda, K;
      if (step == 9) {
        ea.scale = 1.0f; Wp = W_MOUT;
        if (hyb) { Ap = (const u16*)(p.ws + OFF_O); lda = 2048; K = 2048; } else { Ap = (const u16*)(p.ws + OFF_NO); lda = 1024; K = 1024; }
      } else {
        ea.scale = 0.5f; Ap = ACT; lda = DFF; K = DFF; Wp = (const u16*)(p.ws + OFF_W_FOUT0 + (step == 2 ? 0 : 1) * SZ_W_FOUT);
      }
#if SKIP_MIX
      if (step == 9) {
        const size_t n = (size_t)M_TOK * DM;
        for (size_t i = (size_t)lbid() * NTHREADS + ltid(); i < n; i += (size_t)gridDim.x * NTHREADS) H[i] *= ALPHA;
        break;
      }
#endif
      gemm_phase<EPI_RES>(Ap, lda, Wp, M_TOK, 1024, K, ea, smem, wv_);
    } break;
    case 3: case 10: case 13: break;
    case 4: {
#if !SKIP_MIX
      if (hyb) {
        EpiArgs ea{}; ea.cb = (u16*)(p.ws + OFF_PROJ); ea.f0 = (float*)(p.ws + OFF_GLOG); ea.f1 = (float*)(p.ws + OFF_SDTL);
        gemm_phase<EPI_HYBIN>(HB, DM, W_MIN, M_TOK, HYB_IN_NP, 1024, ea, smem, wv_);
      } else {
        EpiArgs ea{}; ea.cb = (u16*)(p.ws + OFF_PROJ); ea.f0 = (float*)(p.ws + OFF_NGATE);
        gemm_phase<EPI_NSAIN>(HB, DM, W_MIN, M_TOK, NSA_IN_NP, 1024, ea, smem, wv_);
      }
#endif
    } break;
    case 5: {
#if !SKIP_MIX
#ifndef NO_HPREP
      if (hyb) hyb_prep(p, li);
#endif
#ifndef NO_NPREP
      if (!hyb) nsa_prep(p, li);
#endif
#endif
    } break;
    case 6: {
#if !SKIP_MIX
      if (hyb) {
        for (int it0 = lbid(); it0 < 256; it0 += gridDim.x) {
          const int item = (gridDim.x == 256) ? ((it0 & 7) * 32 + (it0 >> 3)) : it0;
          scan_item(p, li, item, smem);
        }
      } else {
#pragma unroll 1
        for (int s = 0; s < 2; ++s) {
          EpiArgs ea{}; ea.cb = (u16*)(p.ws + (s == 0 ? OFF_HIDK : OFF_HIDV)); ea.ldc = 256;
          gemm_phase<EPI_SILU>((const u16*)(p.ws + (s == 0 ? OFF_FLATK : OFF_FLATV)), 2048, (const u16*)(p.ws + OFF_W_C1 + s * SZ_W_C1), 2048, 256, 2048, ea, smem, wv_, s * 8);
        }
#pragma unroll 1
        for (int s = 0; s < 2; ++s) {
          EpiArgs ea{}; ea.cb = (u16*)(p.ws + (s == 0 ? OFF_KCMP : OFF_VCMP)); ea.ldc = 64; ea.nvalid = 64;
          gemm_phase<EPI_PLAIN>((const u16*)(p.ws + (s == 0 ? OFF_HIDK : OFF_HIDV)), 256, (const u16*)(p.ws + OFF_W_C2 + s * SZ_W_C2), 2048, 256, 256, ea, smem, wv_, s * 8);
        }
      }
#endif
    } break;
    case 7: {
#if !SKIP_MIX
#ifndef NO_HPOST
      if (hyb) hyb_post(p, li);
#endif
#endif
    } break;
    case 8: {
#if !SKIP_MIX
      #ifndef NO_ATTN
      if (!hyb) {
        for (int it0 = lbid(); it0 < 1024; it0 += gridDim.x) {
          int item = it0, flip = (it0 >> 8) & 1;
          if (gridDim.x == 256) {
            const int r = it0 >> 8, lix = (lbid() >> 3) + 32 * r;
            item = ((lbid() & 7) << 7) | lix; flip = lix >> 6;
          }
          nsa_attn_item(p, item, flip, smem);
        }
      }
#endif
#endif
    } break;
  }
}


#define XB_TMO      128
#define XB_XCNT(j)  (256  + 64 * (j))
#define XB_XSUB(j)  (1280 + 64 * (j))
#define XB_XGEN(j)  (2304 + 64 * (j))
#define XB_TOP      3328
#define XB_TOPGEN   3392
#define XCD_BAR_WORDS 3456
#define XL_SUB(j) (3456 + 64 * (j))
#define XL_GEN(j) (4480 + 64 * (j))
#define XL_MAP(g) (5504 + (g))
#define XL_BAD    5568
#define ALL_BAR_WORDS 5632
#define XB_SPIN_CAP (1u << 18)
#define LAS __attribute__((address_space(3)))
DI unsigned xb_ld(unsigned* p)              { return __hip_atomic_load(p, __ATOMIC_RELAXED, __HIP_MEMORY_SCOPE_AGENT); }
DI unsigned xb_add(unsigned* p, unsigned v) { return __hip_atomic_fetch_add(p, v, __ATOMIC_RELAXED, __HIP_MEMORY_SCOPE_AGENT); }
DI unsigned xb_xcc_id() { return (unsigned)__builtin_amdgcn_s_getreg((3 << 11) | 20) & 0xFu; }
#define XB_SPIN(cond, bar) do { unsigned _sp = 0; while (cond) { __builtin_amdgcn_s_sleep(1); \
    if ((++_sp & 255u) == 0u) { if (xb_ld(&(bar)[XB_TMO])) break; if (_sp > XB_SPIN_CAP) { atomicAdd(&(bar)[XB_TMO], 1u); break; } } } } while (0)
struct XcdBarrier { unsigned* bar; unsigned x; volatile LAS unsigned* st; };
DI XcdBarrier xcd_barrier_post(unsigned* bar, volatile LAS unsigned* st, int tid) {
  XcdBarrier b; b.bar = bar; b.x = xb_xcc_id(); b.st = st;
  if (tid == 0) (void)xb_add(&bar[XB_XCNT(b.x)], 1u);
  return b;
}
DI void xcd_barrier_complete(unsigned* bar, unsigned x, unsigned& nloc, unsigned& nx) {
  const unsigned G = gridDim.x * gridDim.y * gridDim.z;
  unsigned sum, cnt, mine, sp = 0u;
  for (;;) {
    sum = 0u; cnt = 0u; mine = 0u;
#pragma unroll
    for (unsigned j = 0; j < 16; ++j) { const unsigned c = xb_ld(&bar[XB_XCNT(j)]); sum += c; cnt += (c > 0u) ? 1u : 0u; mine = (j == x) ? c : mine; }
    if (sum == G) break;
    __builtin_amdgcn_s_sleep(1);
    if ((++sp & 255u) == 0u) { if (xb_ld(&bar[XB_TMO])) break; if (sp > XB_SPIN_CAP) { atomicAdd(&bar[XB_TMO], 1u); break; } }
  }
  nloc = mine > 0u ? mine : 1u; nx = cnt > 0u ? cnt : 1u;
}
DI void xcd_barrier(const XcdBarrier& b, int tid) {
  asm volatile("s_waitcnt vmcnt(0)" ::: "memory");
  __syncthreads();
  if (tid == 0) {
    unsigned* bar = b.bar;
    __builtin_amdgcn_s_waitcnt(0);
    unsigned nloc = b.st[0], nx = b.st[1];
    if (nloc == 0u) { xcd_barrier_complete(bar, b.x, nloc, nx); b.st[0] = nloc; b.st[1] = nx; }
    const unsigned old = xb_add(&bar[XB_XSUB(b.x)], 1u);
    const unsigned gen = old / nloc;
    if (old + 1u == (gen + 1u) * nloc) {
      __builtin_amdgcn_fence(__ATOMIC_RELEASE, "agent");
      asm volatile("s_waitcnt vmcnt(0)" ::: "memory");
      const unsigned og = xb_add(&bar[XB_TOP], 1u);
      const unsigned tg = og / nx;
      if (og + 1u == (tg + 1u) * nx) xb_add(&bar[XB_TOPGEN], 1u);
      else XB_SPIN(xb_ld(&bar[XB_TOPGEN]) == tg, bar);
      __builtin_amdgcn_fence(__ATOMIC_ACQUIRE, "agent");
      xb_add(&bar[XB_XGEN(b.x)], 1u);
      asm volatile("s_waitcnt vmcnt(0)" ::: "memory");
    } else {
      XB_SPIN(xb_ld(&bar[XB_XGEN(b.x)]) == gen, bar);
      __builtin_amdgcn_fence(__ATOMIC_ACQUIRE, "agent");
      asm volatile("s_waitcnt vmcnt(0)" ::: "memory");
    }
  }
  __syncthreads();
}

DI void xcc_local_barrier(const XcdBarrier& b, int tid) {
  asm volatile("s_waitcnt vmcnt(0)" ::: "memory");
  __syncthreads();
  if (tid == 0) {
    unsigned* bar = b.bar;
    __builtin_amdgcn_s_waitcnt(0);
    const unsigned old = xb_add(&bar[XL_SUB(b.x)], 1u);
    const unsigned gen = old / 32u;
    if (old + 1u == (gen + 1u) * 32u) {
      __builtin_amdgcn_fence(__ATOMIC_RELEASE, "agent");
      asm volatile("s_waitcnt vmcnt(0)" ::: "memory");
      __builtin_amdgcn_fence(__ATOMIC_ACQUIRE, "agent");
      xb_add(&bar[XL_GEN(b.x)], 1u);
      asm volatile("s_waitcnt vmcnt(0)" ::: "memory");
    } else {
      XB_SPIN(xb_ld(&bar[XL_GEN(b.x)]) == gen, bar);
      __builtin_amdgcn_fence(__ATOMIC_ACQUIRE, "agent");
      asm volatile("s_waitcnt vmcnt(0)" ::: "memory");
    }
  }
  __syncthreads();
}

__global__ void __launch_bounds__(NTHREADS, 2) mega_kernel(Params p, int ph_begin, int ph_end) {
  __shared__ __attribute__((aligned(16))) char smem[131072];
  cg::grid_group grid = cg::this_grid();
  const int wave_id = __builtin_amdgcn_readfirstlane(threadIdx.x >> 6);
  __shared__ uint4 xb_words;
  if (threadIdx.x == 0) xb_words = make_uint4(0u, 0u, 0u, 0u);
  __syncthreads();
  const XcdBarrier xb = xcd_barrier_post((unsigned*)(p.ws + OFF_BAR), (volatile LAS unsigned*)&xb_words, (int)threadIdx.x);
  if (threadIdx.x == 0) {
    unsigned* bar = (unsigned*)(p.ws + OFF_BAR);
    const unsigned v = xb.x + 1u;
    const unsigned old = atomicCAS(&bar[XL_MAP(blockIdx.x & 7)], 0u, v);
    if (old != 0u && old != v) atomicOr(&bar[XL_BAD], 1u);
  }
  bool affine_ok = false;
  for (int ph = ph_begin; ph < ph_end; ++ph) {
    Params q = p;
    { size_t zoff = 0; asm volatile("" : "+s"(zoff)); q.ws = p.ws + zoff; }
    q.wave = wave_id;
    run_phase(q, ph, smem);
#ifdef PROBE_DOUBLE
    if (ph > 0) {
      const int step = (ph - 1) % PH_PER_LAYER;
      if ((PROBE_DOUBLE == 1 && (step == 1 || step == 11 || step == 4)) ||
          (PROBE_DOUBLE == 2 && (step == 0 || step == 5 || step == 7 || step == 8)) ) {
        grid.sync();
        run_phase(q, ph, smem);
      }
    }
#endif
    if (ph + 1 < ph_end) {
      if (ph_end < 0) grid.sync();
      {
        const int wv_ = wave_id;
        bool local_ok = false;
        if (affine_ok && ph >= 2) {
          const int pc = (int)PROG[ph - 1], bstep = pc & 15, bnsa = (pc >> 4) & 1;
          local_ok = !(bstep == 3 || bstep == 10 || bstep == 13 || (bnsa && bstep >= 5 && bstep <= 7));
        }
        if (local_ok) xcc_local_barrier(xb, ltid());
        else xcd_barrier(xb, ltid());
        if (ph == 0) {
          if (threadIdx.x == 0 && xb_words.x != 32u) atomicOr(&xb.bar[XL_BAD], 1u);
        } else if (ph == 1) {
          if (threadIdx.x == 0) xb_words.z = (xb_ld(&xb.bar[XL_BAD]) == 0u && gridDim.x == 256) ? 1u : 0u;
          __syncthreads();
          affine_ok = xb_words.z != 0u;
        }
      }
    }
  }
}

extern "C" void kernel_launch(void* const* d_in, const int* in_sizes, int n_in, void* d_out, int out_size, void* d_ws, size_t ws_size,
                              hipStream_t stream) {
  static int grid_blocks = 0;
  if (!grid_blocks) {
    int dev = 0, cus = 0, per_cu = 0;
    hipGetDevice(&dev);
    hipDeviceGetAttribute(&cus, hipDeviceAttributeMultiprocessorCount, dev);
    hipOccupancyMaxActiveBlocksPerMultiprocessor(&per_cu, mega_kernel, NTHREADS, 0);
    if (per_cu > 1) per_cu = 1;
    if (per_cu < 1) per_cu = 1;
    grid_blocks = cus * per_cu;
  }
  Params p{};
  p.x = (const float*)d_in[0]; p.pos = (const int*)d_in[1];
  p.ln_g = (const float*)d_in[2]; p.ln_b = (const float*)d_in[3];
  p.ffn_w_in = (const float*)d_in[4]; p.ffn_w_out = (const float*)d_in[5];
  p.hyb_w_in = (const float*)d_in[6]; p.gdn_conv_w = (const float*)d_in[7]; p.gdn_a_log = (const float*)d_in[8];
  p.gdn_dt_bias = (const float*)d_in[9]; p.gdn_norm_w = (const float*)d_in[10];
  p.ssd_conv_w = (const float*)d_in[11]; p.ssd_conv_b = (const float*)d_in[12]; p.ssd_a_log = (const float*)d_in[13];
  p.ssd_dt_bias = (const float*)d_in[14]; p.ssd_d = (const float*)d_in[15]; p.ssd_norm_w = (const float*)d_in[16];
  p.hyb_w_out = (const float*)d_in[17];
  p.nsa_w_in = (const float*)d_in[18]; p.nsa_cmp_pos = (const float*)d_in[19]; p.nsa_cmp_w1 = (const float*)d_in[20];
  p.nsa_cmp_w2 = (const float*)d_in[21]; p.nsa_w_out = (const float*)d_in[22];
  p.out = (float*)d_out;
  p.ws = (char*)d_ws;
  hipMemsetAsync((char*)d_ws + OFF_BAR, 0, ALL_BAR_WORDS * 4, stream);
#if USE_COOP
  int b0 = 0, b1 = N_PHASES;
  void* args[] = {&p, &b0, &b1};
  hipError_t e = hipLaunchCooperativeKernel((void*)mega_kernel, dim3(grid_blocks), dim3(NTHREADS), args, 0, stream);
  if (e != hipSuccess) fprintf(stderr, "cooperative launch failed: %s (grid %d)\n", hipGetErrorString(e), grid_blocks);
#else
  for (int ph = 0; ph < N_PHASES; ++ph) mega_kernel<<<dim3(grid_blocks), dim3(NTHREADS), 0, stream>>>(p, ph, ph + 1);
#endif
}
```
